# Optimizing an MI355X kernel written in HIP

```python
import math
import jax, jax.numpy as jnp
from jax import lax
import numpy as np

D_MODEL = 2048
BATCH = 4
SEQ = 4096
DEPTH = 1
DEC_BATCH = 8
DEC_SEQ = 64
PAST_LEN = 1024

CHUNK = 64
N_META = 16
Q_BLOCK = 128
EPS = 1e-6
N_DIFF_HEADS = 8
DIFF_HEAD_DIM = 64
DIFF_V_DIM = 2 * DIFF_HEAD_DIM
D_DIFF_QK = N_DIFF_HEADS * 2 * DIFF_HEAD_DIM
D_DIFF = N_DIFF_HEADS * DIFF_V_DIM
DIFF_SCALE = DIFF_HEAD_DIM ** -0.5
N_MLA_HEADS = 8
MLA_NOPE_DIM = 128
MLA_ROPE_DIM = 64
MLA_V_DIM = 128
MLA_Q_LORA = 512
MLA_KV_LORA = 256
D_MLA = N_MLA_HEADS * MLA_V_DIM
MLA_SCALE = (MLA_NOPE_DIM + MLA_ROPE_DIM) ** -0.5
ROPE_THETA = 10000.0
D_MIX = D_DIFF + D_MLA
D_IN = 2 * D_DIFF_QK + D_DIFF + MLA_Q_LORA + MLA_KV_LORA + MLA_ROPE_DIM
OFF_K = D_DIFF_QK
OFF_V = 2 * D_DIFF_QK
OFF_CQ = OFF_V + D_DIFF
OFF_CKV = OFF_CQ + MLA_Q_LORA
OFF_KR = OFF_CKV + MLA_KV_LORA
REL_BUCKETS = 32
REL_MAX_DIST = 128
D_FF = ((8 * D_MODEL // 3 + 255) // 256) * 256

kernel_name = 'hymba_diff_mla_streaming_encoder_step'


def rmsnorm(x, g):
    xf = x.astype(jnp.float32)
    y = xf * lax.rsqrt(jnp.mean(xf * xf, axis=-1, keepdims=True) + EPS)
    return (y * g.astype(jnp.float32)).astype(x.dtype)


def rope(x, pos):
    half = x.shape[-1] // 2
    inv_freq = ROPE_THETA ** (-jnp.arange(half, dtype=jnp.float32) / half)
    ang = pos.astype(jnp.float32)[:, None] * inv_freq[None, :]
    shape = (1, pos.shape[0]) + (1,) * (x.ndim - 3) + (half,)
    cos = jnp.cos(ang).reshape(shape)
    sin = jnp.sin(ang).reshape(shape)
    xf = x.astype(jnp.float32)
    x1, x2 = xf[..., :half], xf[..., half:]
    return jnp.concatenate([x1 * cos - x2 * sin, x1 * sin + x2 * cos], axis=-1).astype(x.dtype)


def t5_bucket(rel):
    nb = REL_BUCKETS // 2
    max_exact = nb // 2
    ret = jnp.where(rel > 0, nb, 0)
    n = jnp.abs(rel)
    large = max_exact + (jnp.log(jnp.maximum(n, 1).astype(jnp.float32) / max_exact)
                         / math.log(REL_MAX_DIST / max_exact) * (nb - max_exact)).astype(jnp.int32)
    large = jnp.minimum(large, nb - 1)
    return ret + jnp.where(n < max_exact, n, large)


def project(h, pos, lp):
    B, L, _ = h.shape
    z = h @ lp['w_in']
    qd = z[..., :OFF_K].reshape(B, L, N_DIFF_HEADS, 2, DIFF_HEAD_DIM)
    kd = z[..., OFF_K:OFF_V].reshape(B, L, N_DIFF_HEADS, 2, DIFF_HEAD_DIM)
    vd = z[..., OFF_V:OFF_CQ].reshape(B, L, N_DIFF_HEADS, DIFF_V_DIM)
    cq = rmsnorm(z[..., OFF_CQ:OFF_CKV], lp['mla_q_norm_g'])
    qm = (cq @ lp['mla_w_uq']).reshape(B, L, N_MLA_HEADS, MLA_NOPE_DIM + MLA_ROPE_DIM)
    qm = jnp.concatenate([qm[..., :MLA_NOPE_DIM], rope(qm[..., MLA_NOPE_DIM:], pos)], axis=-1)
    ckv = rmsnorm(z[..., OFF_CKV:OFF_KR], lp['mla_kv_norm_g'])
    krope = rope(z[..., OFF_KR:], pos)
    return qd, kd, vd, qm, ckv, krope


def expand_latent(ckv, w_ukv):
    B, K, _ = ckv.shape
    kv = (ckv @ w_ukv).reshape(B, K, N_MLA_HEADS, MLA_NOPE_DIM + MLA_V_DIM)
    return kv[..., :MLA_NOPE_DIM], kv[..., MLA_NOPE_DIM:]


def attend_block(qd, qm, qpos, qchunk, kd, vd, km, krope, vm, kpos, kchunk, rel_bias, lam):
    neg = jnp.finfo(jnp.float32).min
    visible = kchunk[None, :] <= qchunk[:, None]
    bias = jnp.moveaxis(rel_bias[t5_bucket(kpos[None, :] - qpos[:, None])], -1, 0).astype(jnp.float32)
    s = jnp.einsum('bqhcd,bkhcd->bhcqk', qd, kd).astype(jnp.float32) * DIFF_SCALE + bias[None, :, None]
    p = jax.nn.softmax(jnp.where(visible, s, neg), axis=-1)
    p = p[:, :, 0] - lam * p[:, :, 1]
    o_d = jnp.einsum('bhqk,bkhe->bqhe', p.astype(vd.dtype), vd)
    qn, qr = qm[..., :MLA_NOPE_DIM], qm[..., MLA_NOPE_DIM:]
    sm = (jnp.einsum('bqhd,bkhd->bhqk', qn, km)
          + jnp.einsum('bqhr,bkr->bhqk', qr, krope)).astype(jnp.float32) * MLA_SCALE
    pm = jax.nn.softmax(jnp.where(visible, sm, neg), axis=-1)
    o_m = jnp.einsum('bhqk,bkhe->bqhe', pm.astype(vm.dtype), vm)
    return o_d, o_m


def blocked_attention(qd, qm, qpos, qchunk, kd, vd, km, krope, vm, kpos, kchunk, rel_bias, lam):
    L = qd.shape[1]
    nb = -(-L // Q_BLOCK)
    pad = nb * Q_BLOCK - L

    def to_blocks(a):
        a = jnp.pad(a, [(0, 0), (0, pad)] + [(0, 0)] * (a.ndim - 2))
        a = a.reshape((a.shape[0], nb, Q_BLOCK) + a.shape[2:])
        return jnp.moveaxis(a, 1, 0)

    def from_blocks(a):
        a = jnp.moveaxis(a, 0, 1)
        return a.reshape((a.shape[0], nb * Q_BLOCK) + a.shape[3:])[:, :L]

    qpos_b = jnp.pad(qpos, (0, pad), mode='edge').reshape(nb, Q_BLOCK)
    qchunk_b = jnp.pad(qchunk, (0, pad), mode='edge').reshape(nb, Q_BLOCK)

    def one_block(blk):
        bqd, bqm, bpos, bchunk = blk
        return attend_block(bqd, bqm, bpos, bchunk, kd, vd, km, krope, vm, kpos, kchunk, rel_bias, lam)

    o_d, o_m = lax.map(one_block, (to_blocks(qd), to_blocks(qm), qpos_b, qchunk_b))
    return from_blocks(o_d), from_blocks(o_m)


def trunk_layer(x, pos, chunk, past, lp, rel_bias, lam_init):
    B, L, _ = x.shape
    h = rmsnorm(x, lp['norm_attn_g'])
    qd, kd, vd, qm, ckv, krope = project(h, pos, lp)
    lamp = lp['diff_lambda'].astype(jnp.float32)
    lam = (jnp.exp(jnp.sum(lamp[0] * lamp[1])) - jnp.exp(jnp.sum(lamp[2] * lamp[3])) + lam_init)
    if past is None:
        km, vm = expand_latent(ckv, lp['mla_w_ukv'])
        o_d, o_m = blocked_attention(qd, qm, pos, chunk, kd, vd, km, krope, vm, pos, chunk, rel_bias, lam)
    else:
        pk, pv, pckv, pkr = past
        P = pk.shape[1]
        kd_all = jnp.concatenate([pk.astype(kd.dtype), kd], axis=1)
        vd_all = jnp.concatenate([pv.astype(vd.dtype), vd], axis=1)
        ckv_all = jnp.concatenate([pckv.astype(ckv.dtype), ckv], axis=1)
        kr_all = jnp.concatenate([pkr.astype(krope.dtype), krope], axis=1)
        past_pos = jnp.arange(P, dtype=jnp.int32)
        kpos = jnp.concatenate([past_pos, pos])
        kchunk = jnp.concatenate([past_pos // CHUNK, chunk])
        km, vm = expand_latent(ckv_all, lp['mla_w_ukv'])
        o_d, o_m = attend_block(qd, qm, pos, chunk, kd_all, vd_all, km, kr_all, vm, kpos, kchunk, rel_bias, lam)
    o_d = rmsnorm(o_d, lp['diff_subln_g']) * (1.0 - lam_init)
    mix = jnp.concatenate([o_d.reshape(B, L, D_DIFF), o_m.reshape(B, L, D_MLA)], axis=-1)
    x = x + mix @ lp['w_out']
    h = rmsnorm(x, lp['norm_ffn_g'])
    x = x + (jax.nn.silu(h @ lp['ffn_w_gate']) * (h @ lp['ffn_w_up'])) @ lp['ffn_w_down']
    return x, (kd, vd, ckv, krope)


def setup_inputs(seed: int = 0) -> dict:
    key = jax.random.key(seed)
    ks = jax.random.split(key, 24)
    f32 = jnp.float32

    def nrm(k, shape, scale):
        return jax.random.normal(k, shape, f32) * scale

    def gain(k, shape):
        return 1.0 + 0.02 * jax.random.normal(k, shape, f32)

    return {
        'x_prompt': nrm(ks[0], (BATCH, SEQ, D_MODEL), 1.0),
        'x_sample': nrm(ks[1], (DEC_BATCH, DEC_SEQ, D_MODEL), 1.0),
        'cache_diff_k': nrm(ks[2], (DEPTH, DEC_BATCH, PAST_LEN, N_DIFF_HEADS, 2, DIFF_HEAD_DIM), 1.0),
        'cache_diff_v': nrm(ks[3], (DEPTH, DEC_BATCH, PAST_LEN, N_DIFF_HEADS, DIFF_V_DIM), 1.0),
        'cache_mla_ckv': nrm(ks[4], (DEPTH, DEC_BATCH, PAST_LEN, MLA_KV_LORA), 1.0),
        'cache_mla_krope': nrm(ks[5], (DEPTH, DEC_BATCH, PAST_LEN, MLA_ROPE_DIM), 1.0),
        'meta_tokens': nrm(ks[6], (N_META, D_MODEL), 1.0),
        'rel_bias': nrm(ks[7], (REL_BUCKETS, N_DIFF_HEADS), 0.5),
        'norm_attn_g': gain(ks[8], (DEPTH, D_MODEL)),
        'w_in': nrm(ks[9], (DEPTH, D_MODEL, D_IN), D_MODEL ** -0.5),
        'diff_lambda': nrm(ks[10], (DEPTH, 4, DIFF_HEAD_DIM), 0.1),
        'diff_subln_g': gain(ks[11], (DEPTH, DIFF_V_DIM)),
        'mla_q_norm_g': gain(ks[12], (DEPTH, MLA_Q_LORA)),
        'mla_w_uq': nrm(ks[13], (DEPTH, MLA_Q_LORA, N_MLA_HEADS * (MLA_NOPE_DIM + MLA_ROPE_DIM)), MLA_Q_LORA ** -0.5),
        'mla_kv_norm_g': gain(ks[14], (DEPTH, MLA_KV_LORA)),
        'mla_w_ukv': nrm(ks[15], (DEPTH, MLA_KV_LORA, N_MLA_HEADS * (MLA_NOPE_DIM + MLA_V_DIM)), MLA_KV_LORA ** -0.5),
        'w_out': nrm(ks[16], (DEPTH, D_MIX, D_MODEL), D_MIX ** -0.5),
        'norm_ffn_g': gain(ks[17], (DEPTH, D_MODEL)),
        'ffn_w_gate': nrm(ks[18], (DEPTH, D_MODEL, D_FF), D_MODEL ** -0.5),
        'ffn_w_up': nrm(ks[19], (DEPTH, D_MODEL, D_FF), D_MODEL ** -0.5),
        'ffn_w_down': nrm(ks[20], (DEPTH, D_FF, D_MODEL), D_FF ** -0.5),
        'final_norm_g': gain(ks[21], (D_MODEL,)),
    }


def reference(x_prompt, x_sample, cache_diff_k, cache_diff_v, cache_mla_ckv, cache_mla_krope,
              meta_tokens, rel_bias, norm_attn_g, w_in, diff_lambda, diff_subln_g,
              mla_q_norm_g, mla_w_uq, mla_kv_norm_g, mla_w_ukv, w_out, norm_ffn_g,
              ffn_w_gate, ffn_w_up, ffn_w_down, final_norm_g):
    B, S, _ = x_prompt.shape
    L = N_META + S
    meta = jnp.broadcast_to(meta_tokens[None].astype(x_prompt.dtype), (B, N_META, D_MODEL))
    xp = jnp.concatenate([meta, x_prompt], axis=1)
    pos_p = jnp.arange(L, dtype=jnp.int32)
    chunk_p = jnp.where(pos_p < N_META, -1, (pos_p - N_META) // CHUNK)
    P = cache_diff_k.shape[2]
    Ds = x_sample.shape[1]
    pos_s = P + jnp.arange(Ds, dtype=jnp.int32)
    chunk_s = pos_s // CHUNK
    xs = x_sample
    rows_p = []
    rows_s = []
    for l in range(DEPTH):
        lp = {
            'norm_attn_g': norm_attn_g[l], 'w_in': w_in[l], 'diff_lambda': diff_lambda[l],
            'diff_subln_g': diff_subln_g[l], 'mla_q_norm_g': mla_q_norm_g[l], 'mla_w_uq': mla_w_uq[l],
            'mla_kv_norm_g': mla_kv_norm_g[l], 'mla_w_ukv': mla_w_ukv[l], 'w_out': w_out[l],
            'norm_ffn_g': norm_ffn_g[l], 'ffn_w_gate': ffn_w_gate[l], 'ffn_w_up': ffn_w_up[l],
            'ffn_w_down': ffn_w_down[l],
        }
        lam_init = 0.8 - 0.6 * math.exp(-0.3 * l)
        xp, rp = trunk_layer(xp, pos_p, chunk_p, None, lp, rel_bias, lam_init)
        past = (cache_diff_k[l], cache_diff_v[l], cache_mla_ckv[l], cache_mla_krope[l])
        xs, rs = trunk_layer(xs, pos_s, chunk_s, past, lp, rel_bias, lam_init)
        rows_p.append(rp)
        rows_s.append(rs)
    y_prompt = rmsnorm(xp[:, N_META:], final_norm_g)
    y_sample = rmsnorm(xs, final_norm_g)
    new_diff_k_prompt = jnp.stack([r[0] for r in rows_p])
    new_diff_v_prompt = jnp.stack([r[1] for r in rows_p])
    new_mla_ckv_prompt = jnp.stack([r[2] for r in rows_p])
    new_mla_krope_prompt = jnp.stack([r[3] for r in rows_p])
    new_diff_k_sample = jnp.stack([r[0] for r in rows_s])
    new_diff_v_sample = jnp.stack([r[1] for r in rows_s])
    new_mla_ckv_sample = jnp.stack([r[2] for r in rows_s])
    new_mla_krope_sample = jnp.stack([r[3] for r in rows_s])
    return (y_prompt, y_sample, new_diff_k_prompt, new_diff_v_prompt, new_mla_ckv_prompt,
            new_mla_krope_prompt, new_diff_k_sample, new_diff_v_sample, new_mla_ckv_sample,
            new_mla_krope_sample)
```

```cpp
#include <hip/hip_runtime.h>
#include <hip/hip_cooperative_groups.h>
#include <cstdio>
#include <cstdint>
namespace cg = cooperative_groups;
namespace pg8 {
#define PG8_LAS __attribute__((address_space(3)))
typedef unsigned short bf16_t;
typedef short bf16x8 __attribute__((ext_vector_type(8)));
typedef float f32x4 __attribute__((ext_vector_type(4)));
typedef unsigned u32x4 __attribute__((ext_vector_type(4)));
constexpr int BM = 256, BK = 64, HALF = 128, HTB = HALF * BK * 2  , STAGE_BYTES = 8 * HTB, NXCD = 8, WGM = 8;

__host__ __device__ __forceinline__ int lds_byte(int r, int c) { const int st = (r >> 4) * 2 + (c >> 5), rr = r & 15, cc = c & 31, ob = rr * 64 + cc * 2; return st * 1024 + (ob ^ (((ob >> 9) & 1) << 5)); }
__host__ __device__ __forceinline__ void stage_rc(int b, int& R, int& C) { const int st = b / 1024, sb = b % 1024, swz = sb ^ (((sb >> 9) & 1) << 5); R = (st >> 1) * 16 + swz / 64; C = (st & 1) * 32 + (swz % 64) / 2; }
__host__ __device__ __forceinline__ int perm32(int rho) { const int n = rho >> 4, i = rho & 15; return 8 * (i >> 2) + 4 * n + (i & 3); }

struct Unit { int pm, pn; };
struct Gemm { const bf16_t* A; const bf16_t* Bt; int M, N, K; };

struct StaticOrder {
    int nM, nN, nwg, G, c;
    __host__ __device__ void init(int M, int N, int G_, int c_) { nM = M / BM; nN = N / BM; nwg = nM * nN; G = G_; c = c_; }
    __host__ __device__ bool next(int i, Unit& u) const {
        const long L = (long)i * G + c; if (L >= nwg) return false;
        int wgid = (int)L; { const int q = nwg / NXCD, r = nwg % NXCD, xcd = wgid % NXCD, off = wgid / NXCD; wgid = (xcd < r ? xcd * (q + 1) : r * (q + 1) + (xcd - r) * q) + off; }
        const int nig = WGM * nN, gid = wgid / nig, fm = gid * WGM, gsz = (nM - fm) < WGM ? (nM - fm) : WGM;
        u.pm = fm + ((wgid % nig) % gsz); u.pn = (wgid % nig) / gsz; return true;
    }
    __device__ __forceinline__ void a_ready(const Unit&) const {}
    __device__ __forceinline__ void done(const Unit&) const {}
};

__device__ __forceinline__ unsigned cvt_pk_bf16(float lo, float hi) { unsigned r; asm volatile("v_cvt_pk_bf16_f32 %0, %1, %2" : "=v"(r) : "v"(lo), "v"(hi)); return r; }
typedef float f32x2 __attribute__((ext_vector_type(2)));
template <class Epi, class Sched, bool ALIGN_EPI = false, bool SP2 = false>
__device__ __forceinline__ void gemm_phase(PG8_LAS unsigned char* lds, const Gemm g, const Sched& S, const Epi& E, const int wid) {
    const int lane = (int)__builtin_amdgcn_mbcnt_hi(~0u, __builtin_amdgcn_mbcnt_lo(~0u, 0u)), tid = wid * 64 + lane, wr = wid >> 2, wc = wid & 3, fr = lane & 15, fq = lane >> 4;
    const int K = g.K, nt = K / BK;
    unsigned voffA[2], voffB[2];
#pragma unroll
    for (int i = 0; i < 2; ++i) { int R, C; stage_rc(tid * 16 + i * 8192, R, C); const int Rb = Epi::PERM ? ((R & ~31) + perm32(R & 31)) : R;
        voffA[i] = (unsigned)(R * K + C) * 2u; voffB[i] = (unsigned)(Rb * K + C) * 2u; }
    const size_t kstep = (size_t)(BK * 2);
    const size_t hstep = (size_t)HALF * K * 2;
    const size_t tstep = 2 * hstep;
    const unsigned ldsw = (unsigned)wid * 1024u;
    const int aoff = lds_byte(wr * 64 + fr, fq * 8), boff = lds_byte(wc * 32 + fr, fq * 8);
#define PG8_SA(b, h) (((b) * 2 + (h)) * HTB)
#define PG8_SB(b, h) ((4 + (b) * 2 + (h)) * HTB)
#define PG8_STAGE(bufoff, gbase, voff) do { _Pragma("unroll") for (int _i = 0; _i < 2; ++_i) \
        __builtin_amdgcn_global_load_lds((const unsigned*)((const char*)(gbase) + (voff)[_i]), (PG8_LAS unsigned*)(lds + (bufoff) + ldsw + _i * 8192), 16, 0, 0); } while (0)
#define PG8_LDA(dst, b, h) do { _Pragma("unroll") for (int m = 0; m < 4; ++m) _Pragma("unroll") for (int k = 0; k < 2; ++k) dst[m][k] = *(const PG8_LAS bf16x8*)(lds + PG8_SA(b, h) + aoff + m * 2048 + k * 1024); } while (0)
#define PG8_LDB(dst, b, h) do { _Pragma("unroll") for (int n = 0; n < 2; ++n) _Pragma("unroll") for (int k = 0; k < 2; ++k) dst[n][k] = *(const PG8_LAS bf16x8*)(lds + PG8_SB(b, h) + boff + n * 2048 + k * 1024); } while (0)
#define PG8_MMA(ai, bj, At, Bt) do { __builtin_amdgcn_s_setprio(1); _Pragma("unroll") for (int m = 0; m < 4; ++m) _Pragma("unroll") for (int n = 0; n < 2; ++n) _Pragma("unroll") for (int k = 0; k < 2; ++k) \
        acc[ai][bj][m][n] = __builtin_amdgcn_mfma_f32_16x16x32_bf16(Bt[n][k], At[m][k], acc[ai][bj][m][n], 0, 0, 0); __builtin_amdgcn_s_setprio(0); } while (0)
#define PG8_WAIT_V(n) asm volatile("s_waitcnt vmcnt(" #n ")" ::: "memory")
#define PG8_WAIT_L(n) asm volatile("s_waitcnt lgkmcnt(" #n ")" ::: "memory")
#define PG8_BAR __builtin_amdgcn_s_barrier()
#define PG8_SCHED __builtin_amdgcn_sched_barrier(0)
    Unit cur, nxt; int ui = 0;
    if (!S.next(0, cur)) return;
    f32x4 acc[2][2][4][2];
#pragma unroll
    for (int a = 0; a < 2; ++a)
#pragma unroll
        for (int b = 0; b < 2; ++b)
#pragma unroll
            for (int m = 0; m < 4; ++m)
#pragma unroll
                for (int n = 0; n < 2; ++n) acc[a][b][m][n] = (f32x4){0.f, 0.f, 0.f, 0.f};
    bf16x8 At[4][2], B0[2][2], B1[2][2];
    const char* cA = (const char*)g.A + (size_t)cur.pm * tstep; const char* cB = (const char*)g.Bt + (size_t)cur.pn * tstep;
    S.a_ready(cur);
    if constexpr (SP2) {
        PG8_STAGE(PG8_SB(0, 0), cB, voffB); PG8_STAGE(PG8_SB(0, 1), cB + hstep, voffB); PG8_STAGE(PG8_SA(0, 0), cA, voffA); PG8_STAGE(PG8_SA(0, 1), cA + hstep, voffA);
        if (wr == 1) PG8_BAR;
        PG8_WAIT_V(2); PG8_BAR;
        PG8_STAGE(PG8_SB(1, 0), cB + kstep, voffB); PG8_STAGE(PG8_SA(1, 0), cA + kstep, voffA); PG8_STAGE(PG8_SB(1, 1), cB + hstep + kstep, voffB);
        PG8_WAIT_V(6); PG8_BAR;
    } else {
        PG8_STAGE(PG8_SB(0, 0), cB, voffB); PG8_STAGE(PG8_SA(0, 0), cA, voffA); PG8_STAGE(PG8_SB(0, 1), cB + hstep, voffB); PG8_STAGE(PG8_SA(0, 1), cA + hstep, voffA);
        if (wr == 1) PG8_BAR;
        PG8_WAIT_V(4); PG8_BAR;
        PG8_STAGE(PG8_SB(1, 0), cB + kstep, voffB); PG8_STAGE(PG8_SA(1, 0), cA + kstep, voffA); PG8_STAGE(PG8_SB(1, 1), cB + hstep + kstep, voffB);
        PG8_WAIT_V(6); PG8_BAR;
    }
    for (;;) {
        const bool has_next = S.next(ui + 1, nxt);
        const char* nA = has_next ? (const char*)g.A + (size_t)nxt.pm * tstep : cA; const char* nB = has_next ? (const char*)g.Bt + (size_t)nxt.pn * tstep : cB;
        for (int t = 0; t < nt; t += 2) {
            const bool last = (t == nt - 2);
            const char* a1 = cA + (size_t)(t + 1) * kstep;
            const char* a2 = last ? nA : cA + (size_t)(t + 2) * kstep; const char* b2 = last ? nB : cB + (size_t)(t + 2) * kstep;
            const char* a3 = a2 + kstep; const char* b3 = b2 + kstep;
            if (last && has_next) S.a_ready(nxt);
            if constexpr (SP2) {
            PG8_LDB(B0, 0, 0); PG8_LDB(B1, 0, 1); PG8_SCHED; PG8_LDA(At, 0, 0); PG8_STAGE(PG8_SA(1, 1), a1 + hstep, voffA);
            PG8_WAIT_V(8); PG8_WAIT_L(0); PG8_BAR; PG8_MMA(0, 0, At, B0); PG8_MMA(0, 1, At, B1); PG8_BAR; PG8_SCHED;
            PG8_LDA(At, 0, 1); PG8_STAGE(PG8_SB(0, 0), b2, voffB); PG8_STAGE(PG8_SB(0, 1), b2 + hstep, voffB); PG8_STAGE(PG8_SA(0, 0), a2, voffA);
            PG8_WAIT_V(8); PG8_WAIT_L(0); PG8_BAR; PG8_MMA(1, 0, At, B0); PG8_MMA(1, 1, At, B1); PG8_BAR; PG8_SCHED;
            PG8_LDB(B0, 1, 0); PG8_LDB(B1, 1, 1); PG8_SCHED; PG8_LDA(At, 1, 0); PG8_STAGE(PG8_SA(0, 1), a2 + hstep, voffA);
            PG8_WAIT_V(8); PG8_WAIT_L(0); PG8_BAR; PG8_MMA(0, 0, At, B0); PG8_MMA(0, 1, At, B1); PG8_BAR; PG8_SCHED;
            PG8_LDA(At, 1, 1); PG8_STAGE(PG8_SB(1, 0), b3, voffB); PG8_STAGE(PG8_SB(1, 1), b3 + hstep, voffB); PG8_STAGE(PG8_SA(1, 0), a3, voffA);
            PG8_WAIT_V(8); PG8_WAIT_L(0); PG8_BAR; PG8_MMA(1, 0, At, B0); PG8_MMA(1, 1, At, B1); PG8_BAR; PG8_SCHED;
            } else {
            PG8_LDB(B0, 0, 0); PG8_SCHED; PG8_LDA(At, 0, 0); PG8_STAGE(PG8_SA(1, 1), a1 + hstep, voffA);
            PG8_WAIT_L(8); PG8_BAR; PG8_WAIT_L(0); PG8_MMA(0, 0, At, B0); PG8_BAR; PG8_SCHED;
            PG8_LDB(B1, 0, 1); PG8_STAGE(PG8_SB(0, 0), b2, voffB);
            PG8_BAR; PG8_WAIT_L(0); PG8_MMA(0, 1, At, B1); PG8_BAR;
            PG8_LDA(At, 0, 1); PG8_STAGE(PG8_SA(0, 0), a2, voffA);
            PG8_BAR; PG8_WAIT_L(0); PG8_MMA(1, 0, At, B0); PG8_BAR; PG8_SCHED;
            PG8_STAGE(PG8_SB(0, 1), b2 + hstep, voffB);
            PG8_WAIT_V(6); PG8_BAR; PG8_MMA(1, 1, At, B1); PG8_BAR;
            PG8_LDB(B0, 1, 0); PG8_SCHED; PG8_LDA(At, 1, 0); PG8_STAGE(PG8_SA(0, 1), a2 + hstep, voffA);
            PG8_WAIT_L(8); PG8_BAR; PG8_WAIT_L(0); PG8_MMA(0, 0, At, B0); PG8_BAR; PG8_SCHED;
            PG8_LDB(B1, 1, 1); PG8_STAGE(PG8_SB(1, 0), b3, voffB);
            PG8_BAR; PG8_WAIT_L(0); PG8_MMA(0, 1, At, B1); PG8_BAR;
            PG8_LDA(At, 1, 1); PG8_STAGE(PG8_SA(1, 0), a3, voffA);
            PG8_BAR; PG8_WAIT_L(0); PG8_MMA(1, 0, At, B0); PG8_BAR; PG8_SCHED;
            PG8_STAGE(PG8_SB(1, 1), b3 + hstep, voffB);
            PG8_WAIT_V(6); PG8_BAR; PG8_MMA(1, 1, At, B1); PG8_BAR;
            }
        }
        if constexpr (ALIGN_EPI) { if (wr == 0) PG8_BAR; }
        if constexpr (!Epi::AFTER_DRAIN) { E(acc, cur, wr, wc, fr, fq); S.done(cur); }
        if (!has_next) break;
#pragma unroll
        for (int a = 0; a < 2; ++a)
#pragma unroll
            for (int b = 0; b < 2; ++b)
#pragma unroll
                for (int m = 0; m < 4; ++m)
#pragma unroll
                    for (int n = 0; n < 2; ++n) acc[a][b][m][n] = (f32x4){0.f, 0.f, 0.f, 0.f};
        cur = nxt; cA = nA; cB = nB; ++ui;
        if constexpr (ALIGN_EPI) { if (wr == 1) PG8_BAR; }
    }
    PG8_WAIT_V(0);
    if constexpr (!ALIGN_EPI) { if (wr == 0) PG8_BAR; }
    PG8_BAR;
    if constexpr (Epi::AFTER_DRAIN) { E.fused(acc, cur, wr, wc, fr, fq, lds, wid, lane); S.done(cur); }
#undef PG8_SA
#undef PG8_SB
#undef PG8_STAGE
#undef PG8_LDA
#undef PG8_LDB
#undef PG8_MMA
#undef PG8_WAIT_V
#undef PG8_WAIT_L
#undef PG8_BAR
#undef PG8_SCHED
}
}
#define GAS __attribute__((address_space(1)))
#define LAS __attribute__((address_space(3)))
typedef unsigned short bf16;
typedef unsigned v4u __attribute__((ext_vector_type(4)));
typedef float f32x4 __attribute__((ext_vector_type(4)));
typedef short bf16x8 __attribute__((ext_vector_type(8)));
typedef GAS unsigned gu32;
typedef GAS unsigned long long gu64;
#define RLX_AGENT __ATOMIC_RELAXED, __HIP_MEMORY_SCOPE_AGENT
#define LDS_WAIT() asm volatile("s_waitcnt lgkmcnt(0)" ::: "memory")
#define VM_WAIT() asm volatile("s_waitcnt vmcnt(0)" ::: "memory")
__device__ __forceinline__ unsigned long long rt() { return __builtin_amdgcn_s_memrealtime(); }
__device__ __forceinline__ unsigned f2bf(float f) { unsigned u = __builtin_bit_cast(unsigned, f); return (u + 0x7fffu + ((u >> 16) & 1u)) >> 16; }
__device__ __forceinline__ unsigned pk2(float lo, float hi) { return f2bf(lo) | (f2bf(hi) << 16); }
#ifndef MK_N_LAUNCHES
#define MK_N_LAUNCHES 9
#endif
constexpr int NWAVES = 8, NTHREADS = 512;
constexpr int DM = 2048, NB = 4, SEQ = 4096, NMETA = 16, LP = NMETA + SEQ, DB = 8, DS = 64, PAST = 1024, LS = PAST + DS;
constexpr int NH = 8, DIN = 3904, DINP = 4096, DFF = 5632, QLORA = 512, KVLORA = 256, ROPE = 64, ZC = 832;
constexpr int RP = NB * SEQ, RS = DB * DS, R = RP + RS, MP = R + 256;
constexpr int KPB = 64 + SEQ, KVP = NB * KPB, KVROWS = KVP + DB * LS;
constexpr float EPS = 1e-6f, LOG2E = 1.4426950408889634f;
constexpr float C2D = 0.125f * LOG2E, C2M = 0.07216878364870323f * LOG2E;
constexpr float LAM_INIT = 0.2f;
static_assert(R == 16896 && MP == 17152 && KVROWS == 25344 && LP == 4112, "shapes");
constexpr size_t O_Y = 0, O_KP = (size_t)R * DM, O_VP = O_KP + (size_t)NB * LP * 1024, O_CKVP = O_VP + (size_t)NB * LP * 1024, O_KRP = O_CKVP + (size_t)NB * LP * 256,
                 O_KS = O_KRP + (size_t)NB * LP * 64, O_VS = O_KS + (size_t)DB * DS * 1024, O_CKVS = O_VS + (size_t)DB * DS * 1024, O_KRS = O_CKVS + (size_t)DB * DS * 256, O_END = O_KRS + (size_t)DB * DS * 64;
static_assert(O_END == 74764288, "d_out size");
constexpr size_t DO_H1 = 0, DO_ZC = (size_t)MP * DM * 2, DO_ZC_END = DO_ZC + (size_t)MP * ZC * 4;
constexpr size_t DO_CQN = 0, DO_CKVN = (size_t)R * QLORA * 2, DO_CKVN_END = DO_CKVN + (size_t)KVROWS * KVLORA * 2;
constexpr size_t DO_OSCR = 0;
static_assert(DO_ZC_END <= (size_t)R * DM * 4 && DO_CKVN_END <= DO_ZC, "d_out scratch map");
constexpr size_t MiB = 1u << 20;
constexpr size_t WS_CTL = 0, CTL_ZERO_BYTES = 1 * MiB;
constexpr size_t WS_WIN = 1 * MiB, WS_WUQ = 17 * MiB, WS_WUKV = WS_WUQ + 3 * MiB / 2, WS_WOUT = WS_WUKV + 1 * MiB, WS_WGU = WS_WOUT + 8 * MiB, WS_WD = WS_WGU + 44 * MiB, WS_WEND = WS_WD + 22 * MiB;
constexpr size_t WS_QD = 94 * MiB, WS_KD = WS_QD + 33 * MiB, WS_VD = WS_KD + (size_t)KVROWS * 2048, WS_VM = WS_VD + (size_t)KVROWS * 2048, WS_KM = WS_VM + (size_t)KVROWS * 2048,
                 WS_QM = WS_KM + (size_t)KVROWS * 3072, WS_MIX = WS_QM + (size_t)R * 3072, WS_MIX_END = WS_MIX + (size_t)R * 4096;
constexpr size_t WS_X2B = WS_QD, WS_H = WS_VM;
constexpr size_t WS_PART2 = 466 * MiB, WS_PART3 = 469 * MiB, WS_ROPE = 472 * MiB, WS_END = 474 * MiB;
static_assert(WS_WEND <= WS_QD && WS_MIX_END <= WS_PART2 && WS_X2B + (size_t)R * 4096 <= WS_VM && WS_H + (size_t)R * DFF * 2 <= WS_PART2 && WS_PART2 + (size_t)R * 128 <= WS_PART3 && WS_PART3 + (size_t)R * 128 <= WS_ROPE && WS_ROPE + (size_t)LP * 256 <= WS_END, "d_ws map");
constexpr int CW_QUEUE = 64;
constexpr int CW_BAR = 4096;
constexpr int RING_BYTES = 131072, LDSCTL_OFF = RING_BYTES, MISC_OFF = LDSCTL_OFF + 320, LDS_BYTES = 147456;

typedef float f32x2 __attribute__((ext_vector_type(2)));
typedef unsigned u32x2 __attribute__((ext_vector_type(2)));
__device__ __forceinline__ float wave_sum(float v) {
#pragma unroll
    for (int o = 1; o < 64; o <<= 1) v += __shfl_xor(v, o);
    return v;
}
__device__ __forceinline__ float rsqrt_f(float x) { return 1.0f / sqrtf(x); }

namespace epi {
using pg8::Unit; using pg8::bf16_t; using pg8::cvt_pk_bf16; using pg8::HALF; using pg8::BM; using pg8::u32x4;

struct EpiIn {
    static constexpr bool PERM = true, AFTER_DRAIN = false;
    bf16_t *Qd, *Kd, *Vd; float* zc; float* out;
    __device__ __forceinline__ void st_kv(const f32x4& v0, const f32x4& v1, float* of, bf16_t* ob) const {
        *(f32x4*)of = v0; *(f32x4*)(of + 4) = v1;
        u32x4 w; w.x = cvt_pk_bf16(v0[0], v0[1]); w.y = cvt_pk_bf16(v0[2], v0[3]); w.z = cvt_pk_bf16(v1[0], v1[1]); w.w = cvt_pk_bf16(v1[2], v1[3]);
        *(u32x4*)ob = w;
    }
    __device__ __forceinline__ void operator()(const f32x4 (&acc)[2][2][4][2], const Unit& u, int wr, int wc, int fr_, int fq_) const {
        int fr = fr_, fq = fq_; asm volatile("" : "+v"(fr), "+v"(fq));
        const int pm = u.pm, cat = u.pn >> 2, colt = (u.pn & 3) * 256 + wc * 32 + 8 * fq;
        if (pm == 66) {
            if (wr != 0 || cat == 0) return;
#pragma unroll
            for (int bj = 0; bj < 2; ++bj) { const int col = colt + bj * HALF; const f32x4 v0 = acc[0][bj][0][0], v1 = acc[0][bj][0][1];
                if (cat == 3) { if (col < ZC) { float* z = zc + (size_t)(R + fr) * ZC + col; *(f32x4*)z = v0; *(f32x4*)(z + 4) = v1; } }
                else { for (int b = 0; b < NB; ++b) { const size_t orow = (size_t)b * LP + fr, krow = (size_t)b * KPB + fr;
                        st_kv(v0, v1, out + (cat == 1 ? O_KP : O_VP) + orow * 1024 + col, (cat == 1 ? Kd : Vd) + krow * 1024 + col); } } }
            return;
        }
#pragma unroll
        for (int ai = 0; ai < 2; ++ai)
#pragma unroll
            for (int m = 0; m < 4; ++m) {
                const int rit = ai * HALF + wr * 64 + m * 16 + fr; const size_t r = (size_t)pm * BM + rit;
                size_t orow, krow; size_t obase_k, obase_v;
                if (pm < 64) { const int b = pm >> 4, t = (pm & 15) * 256 + rit; orow = (size_t)b * LP + NMETA + t; krow = (size_t)b * KPB + 64 + t; obase_k = O_KP; obase_v = O_VP; }
                else { const int rr = (pm - 64) * 256 + rit, b = rr >> 6, j = rr & 63; orow = (size_t)b * DS + j; krow = (size_t)KVP + (size_t)b * LS + PAST + j; obase_k = O_KS; obase_v = O_VS; }
#pragma unroll
                for (int bj = 0; bj < 2; ++bj) { const int col = colt + bj * HALF; const f32x4 v0 = acc[ai][bj][m][0], v1 = acc[ai][bj][m][1];
                    if (cat == 0) { u32x4 w; w.x = cvt_pk_bf16(v0[0] * C2D, v0[1] * C2D); w.y = cvt_pk_bf16(v0[2] * C2D, v0[3] * C2D); w.z = cvt_pk_bf16(v1[0] * C2D, v1[1] * C2D); w.w = cvt_pk_bf16(v1[2] * C2D, v1[3] * C2D);
                        *(u32x4*)(Qd + r * 1024 + col) = w; }
                    else if (cat == 1) st_kv(v0, v1, out + obase_k + orow * 1024 + col, Kd + krow * 1024 + col);
                    else if (cat == 2) st_kv(v0, v1, out + obase_v + orow * 1024 + col, Vd + krow * 1024 + col);
                    else if (col < ZC) { float* z = zc + r * ZC + col; *(f32x4*)z = v0; *(f32x4*)(z + 4) = v1; } }
            }
    }
};

struct EpiUq {
    static constexpr bool PERM = true, AFTER_DRAIN = false;
    bf16_t* Qm; const f32x2* rope;
    __device__ __forceinline__ void operator()(const f32x4 (&acc)[2][2][4][2], const Unit& u, int wr, int wc, int fr_, int fq_) const {
        int fr = fr_, fq = fq_; asm volatile("" : "+v"(fr), "+v"(fq));
#pragma unroll
        for (int bj = 0; bj < 2; ++bj) { const int n8 = u.pn * BM + bj * HALF + wc * 32 + 8 * fq, h = n8 / 192, j8 = n8 - h * 192;
#pragma unroll
            for (int ai = 0; ai < 2; ++ai)
#pragma unroll
                for (int m = 0; m < 4; ++m) {
                    const int rit = ai * HALF + wr * 64 + m * 16 + fr; const size_t r = (size_t)u.pm * BM + rit;
                    const f32x4 v0 = acc[ai][bj][m][0] * C2M, v1 = acc[ai][bj][m][1] * C2M; bf16_t* qrow = Qm + r * 1536 + h * 192;
                    if (j8 < 128) { u32x4 w; w.x = cvt_pk_bf16(v0[0], v0[1]); w.y = cvt_pk_bf16(v0[2], v0[3]); w.z = cvt_pk_bf16(v1[0], v1[1]); w.w = cvt_pk_bf16(v1[2], v1[3]); *(u32x4*)(qrow + j8) = w; }
                    else { const int i0 = (j8 - 128) >> 1; const int pos = (u.pm < 64) ? NMETA + (int)(r & 4095) : PAST + (int)((r - RP) & 63);
                        const f32x4 cs0 = *(const f32x4*)(rope + (size_t)pos * 32 + i0), cs1 = *(const f32x4*)(rope + (size_t)pos * 32 + i0 + 2);
                        const float a0 = v0[0] * cs0[0] - v0[1] * cs0[1], b0 = v0[0] * cs0[1] + v0[1] * cs0[0];
                        const float a1 = v0[2] * cs0[2] - v0[3] * cs0[3], b1 = v0[2] * cs0[3] + v0[3] * cs0[2];
                        const float a2 = v1[0] * cs1[0] - v1[1] * cs1[1], b2 = v1[0] * cs1[1] + v1[1] * cs1[0];
                        const float a3 = v1[2] * cs1[2] - v1[3] * cs1[3], b3 = v1[2] * cs1[3] + v1[3] * cs1[2];
                        u32x2 wa, wb; wa.x = cvt_pk_bf16(a0, a1); wa.y = cvt_pk_bf16(a2, a3); wb.x = cvt_pk_bf16(b0, b1); wb.y = cvt_pk_bf16(b2, b3);
                        *(u32x2*)(qrow + 128 + i0) = wa; *(u32x2*)(qrow + 160 + i0) = wb; }
                } }
    }
};

struct EpiUkv {
    static constexpr bool PERM = true, AFTER_DRAIN = false;
    bf16_t *Km, *Vm;
    __device__ __forceinline__ void operator()(const f32x4 (&acc)[2][2][4][2], const Unit& u, int wr, int wc, int fr_, int fq_) const {
        int fr = fr_, fq = fq_; asm volatile("" : "+v"(fr), "+v"(fq));
        const int c8 = wc * 32 + 8 * fq;
#pragma unroll
        for (int ai = 0; ai < 2; ++ai)
#pragma unroll
            for (int m = 0; m < 4; ++m) { const size_t r = (size_t)u.pm * BM + ai * HALF + wr * 64 + m * 16 + fr;
#pragma unroll
                for (int bj = 0; bj < 2; ++bj) { const f32x4 v0 = acc[ai][bj][m][0], v1 = acc[ai][bj][m][1];
                    u32x4 w; w.x = cvt_pk_bf16(v0[0], v0[1]); w.y = cvt_pk_bf16(v0[2], v0[3]); w.z = cvt_pk_bf16(v1[0], v1[1]); w.w = cvt_pk_bf16(v1[2], v1[3]);
                    if (bj == 0) *(u32x4*)(Km + r * 1536 + u.pn * 192 + c8) = w; else *(u32x4*)(Vm + r * 1024 + u.pn * 128 + c8) = w; } }
    }
};

template <bool WITH_BF16> struct EpiRes {
    static constexpr bool PERM = false, AFTER_DRAIN = false;
    const float* xp; const float* xs; float* xo; bf16_t* xb; float* part;
    __device__ __forceinline__ void operator()(const f32x4 (&acc)[2][2][4][2], const Unit& u, int wr, int wc, int fr_, int fq_) const {
        int fr = fr_, fq = fq_; asm volatile("" : "+v"(fr), "+v"(fq));
        const int col0 = u.pn * BM + wc * 32 + 4 * fq;
#pragma unroll
        for (int ai = 0; ai < 2; ++ai)
#pragma unroll
            for (int m = 0; m < 4; ++m) { const size_t r = (size_t)u.pm * BM + ai * HALF + wr * 64 + m * 16 + fr;
                const float* xin = (u.pm < 64) ? xp + r * DM : xs + (r - RP) * DM; float ss = 0.f;
#pragma unroll
                for (int bj = 0; bj < 2; ++bj)
#pragma unroll
                    for (int n = 0; n < 2; ++n) { const int col = col0 + bj * HALF + n * 16; const f32x4 v = *(const f32x4*)(xin + col) + acc[ai][bj][m][n];
                        *(f32x4*)(xo + r * DM + col) = v; ss += (v[0] * v[0] + v[1] * v[1]) + (v[2] * v[2] + v[3] * v[3]);
                        if (WITH_BF16) { u32x2 w; w.x = cvt_pk_bf16(v[0], v[1]); w.y = cvt_pk_bf16(v[2], v[3]); *(u32x2*)(xb + r * DM + col) = w; } }
                ss += __shfl_xor(ss, 16); ss += __shfl_xor(ss, 32);
                if (fq == 0) part[r * 32 + u.pn * 4 + wc] = ss; }
    }
};

struct EpiGU {
    static constexpr bool PERM = true, AFTER_DRAIN = false;
    bf16_t* H; const float* part;
    __device__ __forceinline__ static float silu_mul(float g, float uu) { return g * uu * __builtin_amdgcn_rcpf(1.0f + __builtin_amdgcn_exp2f(-g * LOG2E)); }
    __device__ __forceinline__ void operator()(const f32x4 (&acc)[2][2][4][2], const Unit& u, int wr, int wc, int fr_, int fq_) const {
        int fr = fr_, fq = fq_; asm volatile("" : "+v"(fr), "+v"(fq));
        const int col = u.pn * HALF + wc * 32 + 8 * fq;
#pragma unroll
        for (int ai = 0; ai < 2; ++ai)
#pragma unroll
            for (int m = 0; m < 4; ++m) { const size_t r = (size_t)u.pm * BM + ai * HALF + wr * 64 + m * 16 + fr;
                const f32x4* pp = (const f32x4*)(part + r * 32); f32x4 s4 = pp[0];
#pragma unroll
                for (int i = 1; i < 8; ++i) s4 += pp[i];
                const float rstd = rsqrt_f(((s4[0] + s4[1]) + (s4[2] + s4[3])) * (1.0f / DM) + EPS);
                const f32x4 g0 = acc[ai][0][m][0] * rstd, g1 = acc[ai][0][m][1] * rstd, u0 = acc[ai][1][m][0] * rstd, u1 = acc[ai][1][m][1] * rstd;
                u32x4 w; w.x = cvt_pk_bf16(silu_mul(g0[0], u0[0]), silu_mul(g0[1], u0[1])); w.y = cvt_pk_bf16(silu_mul(g0[2], u0[2]), silu_mul(g0[3], u0[3]));
                w.z = cvt_pk_bf16(silu_mul(g1[0], u1[0]), silu_mul(g1[1], u1[1])); w.w = cvt_pk_bf16(silu_mul(g1[2], u1[2]), silu_mul(g1[3], u1[3]));
                *(u32x4*)(H + r * DFF + col) = w; }
    }
};
}
template <class F> __device__ __forceinline__ void tr_item(const F& f, int K, bf16* WT, int k0, int n0, LAS float* scr, int lane) {
#pragma unroll 8
    for (int i = 0; i < 32; ++i) { const int kk = 2 * i + (lane >> 5); scr[kk * 33 + (lane & 31)] = f(k0 + kk, n0 + (lane & 31)); }
    LDS_WAIT(); asm volatile("" ::: "memory");
    const int c = lane & 7;
#pragma unroll
    for (int j = 0; j < 4; ++j) { const int n = (lane >> 3) + 8 * j; const LAS float* s = scr + (8 * c) * 33 + n;
        v4u o; o.x = pk2(s[0 * 33], s[1 * 33]); o.y = pk2(s[2 * 33], s[3 * 33]); o.z = pk2(s[4 * 33], s[5 * 33]); o.w = pk2(s[6 * 33], s[7 * 33]);
        *(GAS v4u*)(WT + (size_t)(n0 + n) * K + k0 + 8 * c) = o; }
    LDS_WAIT(); asm volatile("" ::: "memory");
}
struct SrcIn { const float* W; __device__ __forceinline__ float operator()(int k, int n) const { return n < DIN ? W[(size_t)k * DIN + n] : 0.f; } };
struct SrcPlain { const float* W; int ld; __device__ __forceinline__ float operator()(int k, int n) const { return W[(size_t)k * ld + n]; } };
struct SrcUq { const float* W; __device__ __forceinline__ float operator()(int k, int n) const { const int h = n / 192, j = n - h * 192;
        const int col = j < 128 ? h * 192 + j : h * 192 + 128 + ((j - 128) >> 1) + 32 * ((j - 128) & 1); return W[(size_t)k * 1536 + col]; } };
struct SrcGU { const float* Wm; const float* g; __device__ __forceinline__ float operator()(int k, int n) const { const int pn = n >> 8, j = n & 127;
        return g[k] * Wm[(size_t)k * DFF + pn * 128 + j]; } };

__device__ __forceinline__ void norm_row_to_bf16(const float* xrow, const float* g, bf16* orow, int lane) {
    GAS unsigned long long* o8 = (GAS unsigned long long*)orow + lane;
    if (!xrow) {
#pragma unroll
        for (int j = 0; j < 8; ++j) o8[64 * j] = 0ull;
        return; }
    const GAS f32x4* xr = (const GAS f32x4*)xrow + lane; const GAS f32x4* gr = (const GAS f32x4*)g + lane;
    f32x4 v[8]; float s = 0.f;
#pragma unroll
    for (int j = 0; j < 8; ++j) { v[j] = xr[64 * j]; s += (v[j].x * v[j].x + v[j].y * v[j].y) + (v[j].z * v[j].z + v[j].w * v[j].w); }
    const float rstd = rsqrt_f(wave_sum(s) * (1.f / DM) + EPS);
#pragma unroll
    for (int j = 0; j < 8; ++j) { const f32x4 gg = gr[64 * j]; o8[64 * j] = (unsigned long long)pk2(v[j].x * rstd * gg.x, v[j].y * rstd * gg.y) | ((unsigned long long)pk2(v[j].z * rstd * gg.z, v[j].w * rstd * gg.w) << 32); }
}
__device__ __forceinline__ void cvt_row1024(const float* src, bf16* dst, int lane) {
    const GAS f32x4* s = (const GAS f32x4*)src + lane; GAS unsigned long long* o8 = (GAS unsigned long long*)dst + lane;
#pragma unroll
    for (int j = 0; j < 4; ++j) { const f32x4 v = s[64 * j]; o8[64 * j] = (unsigned long long)pk2(v.x, v.y) | ((unsigned long long)pk2(v.z, v.w) << 32); }
}
__device__ __forceinline__ void zero_row1024(bf16* dst, int lane) {
    GAS unsigned long long* o8 = (GAS unsigned long long*)dst + lane;
#pragma unroll
    for (int j = 0; j < 4; ++j) o8[64 * j] = 0ull;
}

struct Ptrs {
    const float *x_prompt, *x_sample, *c_dk, *c_dv, *c_ckv, *c_kr, *meta, *rel_bias, *g_attn, *w_in, *lam4, *g_subln, *g_q, *w_uq, *g_kv, *w_ukv, *w_out, *g_ffn, *w_gate, *w_up, *w_down, *g_final;
    float* out; unsigned char* ws;
    bf16 *WinT, *WuqT, *WukvT, *WoutT, *WguT, *WdT, *Qd, *Kd, *Vd, *Vm, *Km, *Qm, *mix, *x2b, *H, *h1, *cqn, *ckvn;
    float *zc, *part2, *part3, *oscr; f32x2* rope; gu32* ctl;
};

__device__ __forceinline__ void p0_prologue(const Ptrs& P, LAS unsigned char* lds, int gw, int NGW, int wave, int lane) {
    LAS float* scr = (LAS float*)(lds + wave * 16384);
    constexpr int I_IN = (DM / 64) * (DINP / 32), I_UQ = (QLORA / 64) * (1536 / 32), I_UKV = (KVLORA / 64) * (2048 / 32), I_OUT = (DM / 64) * (DM / 32), I_GU = (DM / 64) * (2 * DFF / 32), I_D = (DFF / 64) * (DM / 32);
    constexpr int NITEMS = I_IN + I_UQ + I_UKV + I_OUT + I_GU + I_D;
    for (int it = gw; it < NITEMS; it += NGW) {
        int r = it;
        if (r < I_IN) { const int nb = DINP / 32; tr_item(SrcIn{P.w_in}, DM, P.WinT, 64 * (r / nb), 32 * (r % nb), scr, lane); continue; } r -= I_IN;
        if (r < I_UQ) { const int nb = 1536 / 32; tr_item(SrcUq{P.w_uq}, QLORA, P.WuqT, 64 * (r / nb), 32 * (r % nb), scr, lane); continue; } r -= I_UQ;
        if (r < I_UKV) { const int nb = 2048 / 32; tr_item(SrcPlain{P.w_ukv, 2048}, KVLORA, P.WukvT, 64 * (r / nb), 32 * (r % nb), scr, lane); continue; } r -= I_UKV;
        if (r < I_OUT) { const int nb = DM / 32; tr_item(SrcPlain{P.w_out, DM}, DM, P.WoutT, 64 * (r / nb), 32 * (r % nb), scr, lane); continue; } r -= I_OUT;
        if (r < I_GU) { const int nb = 2 * DFF / 32, n0 = 32 * (r % nb); const float* Wm = P.w_gate; if ((n0 >> 7) & 1) Wm = P.w_up;
            tr_item(SrcGU{Wm, P.g_ffn}, DM, P.WguT, 64 * (r / nb), n0, scr, lane); continue; } r -= I_GU;
        { const int nb = DM / 32; tr_item(SrcPlain{P.w_down, DM}, DFF, P.WdT, 64 * (r / nb), 32 * (r % nb), scr, lane); }
    }
    for (int m = gw; m < MP; m += NGW) {
        const float* src = m < RP ? P.x_prompt + (size_t)m * DM : m < R ? P.x_sample + (size_t)(m - RP) * DM : m < R + NMETA ? P.meta + (size_t)(m - R) * DM : nullptr;
        norm_row_to_bf16(src, P.g_attn, P.h1 + (size_t)m * DM, lane);
    }
    for (int m = gw; m < DB * PAST; m += NGW) { const int b = m >> 10, j = m & 1023; const size_t krow = (size_t)KVP + (size_t)b * LS + j;
        cvt_row1024(P.c_dk + (size_t)m * 1024, P.Kd + krow * 1024, lane); cvt_row1024(P.c_dv + (size_t)m * 1024, P.Vd + krow * 1024, lane); }
    for (int m = gw; m < NB * 48; m += NGW) { const size_t krow = (size_t)(m / 48) * KPB + 16 + (m % 48); zero_row1024(P.Kd + krow * 1024, lane); zero_row1024(P.Vd + krow * 1024, lane); }
    for (int e = gw * 64 + lane; e < LP * 32; e += NGW * 64) { const int pos = e >> 5, i = e & 31;
        const float invf = exp2f(-(float)i * (13.287712379549449f / 32.0f)); const float ang = (float)pos * invf;
        const double rev = (double)ang * 0.15915494309189535; const float fr = (float)(rev - floor(rev));
        P.rope[e] = (f32x2){__builtin_amdgcn_cosf(fr), __builtin_amdgcn_sinf(fr)}; }
}

__device__ __forceinline__ void p2_rows(const Ptrs& P, int gw, int NGW, int lane) {
    for (int m = gw; m < R + NMETA; m += NGW) {
        const float* z = P.zc + (size_t)m * ZC;
        int pos, ncopy; size_t krow, orow_ckv, orow_kr;
        if (m < RP) { const int b = m >> 12, t = m & 4095; pos = NMETA + t; ncopy = 1; krow = (size_t)b * KPB + 64 + t; orow_ckv = O_CKVP + ((size_t)b * LP + NMETA + t) * 256; orow_kr = O_KRP + ((size_t)b * LP + NMETA + t) * 64; }
        else if (m < R) { const int rr = m - RP, b = rr >> 6, j = rr & 63; pos = PAST + j; ncopy = 1; krow = (size_t)KVP + (size_t)b * LS + PAST + j; orow_ckv = O_CKVS + (size_t)rr * 256; orow_kr = O_KRS + (size_t)rr * 64; }
        else { const int mm = m - R; pos = mm; ncopy = NB; krow = mm; orow_ckv = O_CKVP + (size_t)mm * 256; orow_kr = O_KRP + (size_t)mm * 64; }
        if (m < R) { const f32x4 a = ((const GAS f32x4*)z)[lane], b4 = ((const GAS f32x4*)z)[64 + lane];
            const float ss = wave_sum((a.x * a.x + a.y * a.y) + (a.z * a.z + a.w * a.w) + (b4.x * b4.x + b4.y * b4.y) + (b4.z * b4.z + b4.w * b4.w));
            const float rstd = rsqrt_f(ss * (1.f / QLORA) + EPS); const f32x4 g0 = ((const GAS f32x4*)P.g_q)[lane], g1 = ((const GAS f32x4*)P.g_q)[64 + lane];
            GAS u32x2* o = (GAS u32x2*)(P.cqn + (size_t)m * QLORA);
            o[lane] = (u32x2){pk2(a.x * rstd * g0.x, a.y * rstd * g0.y), pk2(a.z * rstd * g0.z, a.w * rstd * g0.w)};
            o[64 + lane] = (u32x2){pk2(b4.x * rstd * g1.x, b4.y * rstd * g1.y), pk2(b4.z * rstd * g1.z, b4.w * rstd * g1.w)}; }
        { const f32x4 a = ((const GAS f32x4*)(z + QLORA))[lane]; const float ss = wave_sum((a.x * a.x + a.y * a.y) + (a.z * a.z + a.w * a.w));
            const float rstd = rsqrt_f(ss * (1.f / KVLORA) + EPS); const f32x4 g0 = ((const GAS f32x4*)P.g_kv)[lane];
            const f32x4 v = {a.x * rstd * g0.x, a.y * rstd * g0.y, a.z * rstd * g0.z, a.w * rstd * g0.w}; const u32x2 w = {pk2(v.x, v.y), pk2(v.z, v.w)};
            for (int c = 0; c < ncopy; ++c) { ((GAS f32x4*)(P.out + orow_ckv + (size_t)c * LP * 256))[lane] = v; ((GAS u32x2*)(P.ckvn + (krow + (size_t)c * KPB) * KVLORA))[lane] = w; } }
        { const float xv = z[QLORA + KVLORA + lane]; const float xo = __shfl_xor(xv, 32); const f32x2 cs = P.rope[(size_t)pos * 32 + (lane & 31)];
            const float v = lane < 32 ? xv * cs.x - xo * cs.y : xo * cs.y + xv * cs.x; const bf16 vb = (bf16)f2bf(v);
            for (int c = 0; c < ncopy; ++c) { P.out[orow_kr + (size_t)c * LP * 64 + lane] = v; bf16* kr = P.Km + (krow + (size_t)c * KPB) * 1536 + 128 + lane;
#pragma unroll
                for (int h = 0; h < NH; ++h) kr[h * 192] = vb; } }
    }
    for (int m = gw; m < DB * PAST; m += NGW) { const int b = m >> 10, j = m & 1023; const size_t krow = (size_t)KVP + (size_t)b * LS + j;
        const f32x4 a = ((const GAS f32x4*)(P.c_ckv + (size_t)m * KVLORA))[lane]; ((GAS u32x2*)(P.ckvn + krow * KVLORA))[lane] = (u32x2){pk2(a.x, a.y), pk2(a.z, a.w)};
        const bf16 vb = (bf16)f2bf(P.c_kr[(size_t)m * ROPE + lane]); bf16* kr = P.Km + krow * 1536 + 128 + lane;
#pragma unroll
        for (int h = 0; h < NH; ++h) kr[h * 192] = vb; }
    for (int m = gw; m < NB * 48; m += NGW) { const size_t krow = (size_t)(m / 48) * KPB + 16 + (m % 48);
        ((GAS u32x2*)(P.ckvn + krow * KVLORA))[lane] = (u32x2){0u, 0u}; bf16* kr = P.Km + krow * 1536 + 128 + lane;
#pragma unroll
        for (int h = 0; h < NH; ++h) kr[h * 192] = 0; }
}

__device__ __forceinline__ void p8_final(const Ptrs& P, int gw, int NGW, int lane) {
    for (int m = gw; m < R; m += NGW) {
        const GAS f32x4* pp = (const GAS f32x4*)(P.part3 + (size_t)m * 32); f32x4 s4 = pp[0];
#pragma unroll
        for (int i = 1; i < 8; ++i) s4 += pp[i];
        const float rstd = rsqrt_f(((s4.x + s4.y) + (s4.z + s4.w)) * (1.f / DM) + EPS);
        GAS f32x4* xr = (GAS f32x4*)(P.out + (size_t)m * DM) + lane; const GAS f32x4* gr = (const GAS f32x4*)P.g_final + lane;
#pragma unroll
        for (int j = 0; j < 8; ++j) { const f32x4 v = xr[64 * j], g = gr[64 * j]; xr[64 * j] = (f32x4){v.x * rstd * g.x, v.y * rstd * g.y, v.z * rstd * g.z, v.w * rstd * g.w}; }
    }
}
namespace att {
typedef short s16x4 __attribute__((ext_vector_type(4)));
typedef float f32x16 __attribute__((ext_vector_type(16)));
typedef unsigned u32x4 __attribute__((ext_vector_type(4)));
typedef short v4i16_t __attribute__((ext_vector_type(4)));
typedef LAS const unsigned char* lds_cptr;
constexpr int SLOT_K = 24576, SLOT_V = 16384, LDS_K = 0, LDS_V = 3 * SLOT_K, LDS_BT = LDS_V + 3 * SLOT_V, LDS_WS = LDS_BT + 1536, LDS_Q = LDS_WS + NWAVES * 256, LDS_END = LDS_Q + 64;
static_assert(LDS_END <= RING_BYTES, "attention LDS map");
constexpr int NUNITS = 1024 + 128;
__device__ __forceinline__ int crow(int r, int hi) { return (r & 3) + 8 * (r >> 2) + 4 * hi; }
__device__ __forceinline__ void glds16(const void* gsrc, unsigned lds_dst) { unsigned keep;
    asm volatile("s_mov_b32 %0, m0\n\ts_mov_b32 m0, %2\n\ts_nop 0\n\tglobal_load_lds_dwordx4 %1, off\n\ts_mov_b32 m0, %0" : "=&s"(keep) : "v"(gsrc), "s"(lds_dst) : "memory"); }
typedef float f32x2_t __attribute__((ext_vector_type(2))); typedef __bf16 bf16x2_t __attribute__((ext_vector_type(2)));
__device__ __forceinline__ unsigned cvtpk_s(float lo, float hi) { f32x2_t v = {lo, hi}; bf16x2_t b = __builtin_convertvector(v, bf16x2_t); return __builtin_bit_cast(unsigned, b); }
__device__ __forceinline__ s16x4 vtr(lds_cptr p) { return __builtin_bit_cast(s16x4, __builtin_amdgcn_ds_read_tr16_b64_v4i16((LAS v4i16_t*)p)); }
#define ATT_WAITBAR(N) asm volatile("s_waitcnt vmcnt(" #N ") lgkmcnt(0)\n\ts_barrier" ::: "memory")

template <int DQK>
__device__ __forceinline__ void attn_pass(f32x16 (&o)[4], const bf16* Qw, int qstride, const bf16* Kh, int kstride, const bf16* Vh, int vstride,
                                          int NT, int wnt, bool bias, bool prompt, int qpos0, LAS unsigned char* shm, int lane, int wid) {
    constexpr int KP = DQK / 64, ND0 = DQK / 16;
    const int r32 = lane & 31, hi = lane >> 5;
    const unsigned lds0 = (unsigned)(uintptr_t)shm;
    LAS float* wsf = (LAS float*)(shm + LDS_WS) + wid * 64;
    const LAS float* btab = (const LAS float*)(shm + LDS_BT);
    const bf16* ksrc = Kh + (size_t)lane * kstride + wid * 8;
    const bf16* vsrc = Vh + (size_t)(16 * (wid & 3) + (lane >> 2)) * vstride + (wid >> 2) * 32 + (lane & 3) * 8;
    const unsigned kdst = lds0 + LDS_K + wid * 1024, vdst = lds0 + LDS_V + wid * 1024;
#define ATT_DMA(t, slot) do { const bf16* ks_ = ksrc + (size_t)(t) * 64 * kstride; const bf16* vs_ = vsrc + (size_t)(t) * 64 * vstride; \
        _Pragma("unroll") for (int i_ = 0; i_ < KP; ++i_) glds16(ks_ + i_ * 64, (unsigned)__builtin_amdgcn_readfirstlane(kdst + (slot) * SLOT_K + i_ * 8192)); \
        _Pragma("unroll") for (int i_ = 0; i_ < 2; ++i_) glds16(vs_ + i_ * 64, (unsigned)__builtin_amdgcn_readfirstlane(vdst + (slot) * SLOT_V + i_ * 8192)); } while (0)
    ATT_DMA(0, 0); if (NT > 1) ATT_DMA(1, 1);
    bf16x8 qr[ND0];
    if (wnt > 0) {
#pragma unroll
        for (int d0 = 0; d0 < ND0; ++d0) qr[d0] = *(const bf16x8*)(Qw + (size_t)r32 * qstride + d0 * 16 + hi * 8);
    } else {
#pragma unroll
        for (int d0 = 0; d0 < ND0; ++d0) qr[d0] = (bf16x8){0, 0, 0, 0, 0, 0, 0, 0};
    }
    float mref = 0.f, l = 0.f; f32x16 negm = f32x16{};
#pragma unroll
    for (int d = 0; d < 4; ++d) o[d] = f32x16{};
    int s_cur = 0, s_n2 = 2;
    for (int t = 0; t < NT; ++t) {
        if (t + 1 < NT) { if (KP == 1) ATT_WAITBAR(3); else ATT_WAITBAR(5); } else ATT_WAITBAR(0);
        if (t + 2 < NT) ATT_DMA(t + 2, s_n2);
        if (t < wnt) {
            const lds_cptr kp = (lds_cptr)shm + LDS_K + s_cur * SLOT_K + hi * 1024 + r32 * 16;
            f32x16 p0, p1;
#pragma unroll
            for (int d0 = 0; d0 < ND0; ++d0) {
                const bf16x8 b0 = *(const LAS bf16x8*)(kp + d0 * 2048), b1 = *(const LAS bf16x8*)(kp + d0 * 2048 + 512);
                if (d0 == 0) { p0 = __builtin_amdgcn_mfma_f32_32x32x16_bf16(b0, qr[0], negm, 0, 0, 0); p1 = __builtin_amdgcn_mfma_f32_32x32x16_bf16(b1, qr[0], negm, 0, 0, 0); }
                else { p0 = __builtin_amdgcn_mfma_f32_32x32x16_bf16(b0, qr[d0], p0, 0, 0, 0); p1 = __builtin_amdgcn_mfma_f32_32x32x16_bf16(b1, qr[d0], p1, 0, 0, 0); }
            }
            if (bias) { const int kp0 = prompt ? (t == 0 ? 0 : 64 * t - 48) : 64 * t;
                if (kp0 + 63 - qpos0 > -128) { const LAS float* bt = btab + (kp0 - qpos0 - r32 + 4 * hi + 224);
#pragma unroll
                    for (int r = 0; r < 16; ++r) { p0[r] += bt[(r & 3) + 8 * (r >> 2)]; p1[r] += bt[32 + (r & 3) + 8 * (r >> 2)]; } } }
            if (prompt && t == 0) {
#pragma unroll
                for (int r = 8; r < 16; ++r) p0[r] = -INFINITY;
#pragma unroll
                for (int r = 0; r < 16; ++r) p1[r] = -INFINITY; }
            float rm = fmaxf(p0[0], p1[0]);
#pragma unroll
            for (int r = 1; r < 16; ++r) rm = fmaxf(rm, fmaxf(p0[r], p1[r]));
            { auto rr = __builtin_amdgcn_permlane32_swap(__float_as_uint(rm), __float_as_uint(rm), false, false); rm = fmaxf(__uint_as_float(rr[0]), __uint_as_float(rr[1])); }
            if (t == 0) { mref = rm;
#pragma unroll
                for (int r = 0; r < 16; ++r) { p0[r] -= rm; p1[r] -= rm; negm[r] = -rm; } }
            else if (__any(rm > 8.0f)) { const float dl = fmaxf(rm, 0.f); mref += dl;
#pragma unroll
                for (int r = 0; r < 16; ++r) { p0[r] -= dl; p1[r] -= dl; negm[r] = -mref; }
                const float f = __builtin_amdgcn_exp2f(-dl); l *= f; if (hi == 0) wsf[r32] = f;
                LDS_WAIT();
#pragma unroll
                for (int r = 0; r < 16; ++r) { const float fr_ = wsf[crow(r, hi)];
#pragma unroll
                    for (int d = 0; d < 4; ++d) o[d][r] *= fr_; }
                LDS_WAIT(); }
            float sacc = 0.f;
#pragma unroll
            for (int r = 0; r < 16; ++r) { p0[r] = __builtin_amdgcn_exp2f(p0[r]); p1[r] = __builtin_amdgcn_exp2f(p1[r]); sacc += p0[r] + p1[r]; }
            l += sacc;
            u32x4 pw[4];
#pragma unroll
            for (int k = 0; k < 4; ++k) { pw[0][k] = cvtpk_s(p0[2 * k], p0[2 * k + 1]); pw[1][k] = cvtpk_s(p0[8 + 2 * k], p0[9 + 2 * k]); pw[2][k] = cvtpk_s(p1[2 * k], p1[2 * k + 1]); pw[3][k] = cvtpk_s(p1[8 + 2 * k], p1[9 + 2 * k]); }
            const lds_cptr vp = (lds_cptr)shm + LDS_V + s_cur * SLOT_V + ((lane >> 4) & 1) * 32 + (lane & 3) * 8 + (4 * hi + ((lane & 15) >> 2)) * 64;
#pragma unroll
            for (int d = 0; d < 4; ++d)
#pragma unroll
                for (int ks = 0; ks < 4; ++ks) { const s16x4 lo = vtr(vp + d * 4096 + ks * 1024), hh = vtr(vp + d * 4096 + ks * 1024 + 512);
                    const bf16x8 vf = (bf16x8){lo[0], lo[1], lo[2], lo[3], hh[0], hh[1], hh[2], hh[3]};
                    o[d] = __builtin_amdgcn_mfma_f32_32x32x16_bf16(__builtin_bit_cast(bf16x8, pw[ks]), vf, o[d], 0, 0, 0); }
        }
        s_cur = (s_cur == 2) ? 0 : s_cur + 1; s_n2 = (s_n2 == 2) ? 0 : s_n2 + 1;
    }
    ATT_WAITBAR(0);
    if (wnt > 0) {
        { auto rr = __builtin_amdgcn_permlane32_swap(__float_as_uint(l), __float_as_uint(l), false, false); l = __uint_as_float(rr[0]) + __uint_as_float(rr[1]); }
        if (hi == 0) wsf[32 + r32] = l;
        LDS_WAIT();
#pragma unroll
        for (int r = 0; r < 16; ++r) { const float rl = __builtin_amdgcn_rcpf(wsf[32 + crow(r, hi)]);
#pragma unroll
            for (int d = 0; d < 4; ++d) o[d][r] *= rl; }
        LDS_WAIT();
    }
#undef ATT_DMA
}

__device__ __forceinline__ void store_o(const f32x16 (&o)[4], bf16* dst, LAS unsigned char* shm, int lane, int wid) {
    const int r32 = lane & 31, hi = lane >> 5; LAS bf16* stg = (LAS bf16*)(shm + wid * 8192);
#pragma unroll
    for (int r = 0; r < 16; ++r) { const int orow = crow(r, hi);
#pragma unroll
        for (int d = 0; d < 4; ++d) stg[orow * 128 + d * 32 + r32] = (bf16)f2bf(o[d][r]); }
    LDS_WAIT();
#pragma unroll
    for (int i = 0; i < 8; ++i) { const int id = i * 64 + lane, row = id >> 4, ch = id & 15; const v4u v = *(const LAS v4u*)(stg + row * 128 + ch * 8); *(GAS v4u*)(dst + (size_t)row * DM + ch * 8) = v; }
    LDS_WAIT();
}

__device__ __forceinline__ int t5_bucket(int rel) {
    const int n = rel < 0 ? -rel : rel; int b;
    if (n < 8) b = n; else { const int lg = 33 - __builtin_clz((unsigned)(n * n)); b = lg < 15 ? lg : 15; }
    return b + (rel > 0 ? 16 : 0);
}

__device__ __forceinline__ void attn_phase(const Ptrs& P, LAS unsigned char* shm, int wid) {
    float lam; { float d01 = 0.f, d23 = 0.f;
        for (int i = 0; i < 64; ++i) { d01 += P.lam4[i] * P.lam4[64 + i]; d23 += P.lam4[128 + i] * P.lam4[192 + i]; }
        lam = expf(d01) - expf(d23) + LAM_INIT; }
    volatile LAS unsigned* qw = (volatile LAS unsigned*)(shm + LDS_Q);
    for (;;) {
        int tid = wid * 64 + (int)__builtin_amdgcn_mbcnt_hi(~0u, __builtin_amdgcn_mbcnt_lo(~0u, 0u)); asm volatile("" : "+v"(tid));
        const int lane = tid & 63;
        float* oscr = P.oscr + (size_t)blockIdx.x * 32768 + (size_t)wid * 4096 + lane * 4;
        if (tid == 0) qw[0] = __hip_atomic_fetch_add((unsigned*)(P.ctl + CW_QUEUE), 1u, __ATOMIC_RELAXED, __HIP_MEMORY_SCOPE_AGENT);
        __syncthreads();
        const int u = (int)qw[0];
        if (u >= NUNITS) break;
        int kind, qb, type, b, h;
        if (u < 768) { kind = 0; qb = 15 - (u >> 6); const int v = u & 63; type = v >> 5; b = (v & 31) >> 3; h = v & 7; }
        else if (u < 896) { kind = 1; qb = 0; const int v = u - 768; type = v >> 6; b = (v & 63) >> 3; h = v & 7; }
        else { kind = 0; const int w = u - 896; qb = 3 - (w >> 6); const int v = w & 63; type = v >> 5; b = (v & 31) >> 3; h = v & 7; }
        int NT, wnt, qpos0; size_t qrow0, krow0;
        if (kind == 0) { NT = 4 * qb + 5; wnt = 4 * qb + (wid >> 1) + 2; qpos0 = NMETA + 256 * qb + 32 * wid; qrow0 = (size_t)b * SEQ + 256 * qb + 32 * wid; krow0 = (size_t)b * KPB; }
        else { NT = LS / 64; wnt = wid < 2 ? NT : 0; qpos0 = PAST + 32 * wid; qrow0 = (size_t)RP + (size_t)b * DS + 32 * wid; krow0 = (size_t)KVP + (size_t)b * LS; }
        const bool prompt = (kind == 0);
        f32x16 o[4];
        if (type == 0) {
            if (tid < 352) { const int rel = tid - 224; ((LAS float*)(shm + LDS_BT))[tid] = (P.rel_bias[t5_bucket(rel) * 8 + h] - P.rel_bias[15 * 8 + h]) * LOG2E; }
            attn_pass<64>(o, P.Qd + qrow0 * 1024 + h * 128, 1024, P.Kd + krow0 * 1024 + h * 128, 1024, P.Vd + krow0 * 1024 + h * 128, 1024, NT, wnt, true, prompt, qpos0, shm, lane, wid);
            if (wnt > 0) {
#pragma unroll
                for (int d = 0; d < 4; ++d)
#pragma unroll
                    for (int g = 0; g < 4; ++g) *(f32x4*)(oscr + (d * 4 + g) * 256) = (f32x4){o[d][4 * g], o[d][4 * g + 1], o[d][4 * g + 2], o[d][4 * g + 3]};
            }
            attn_pass<64>(o, P.Qd + qrow0 * 1024 + h * 128 + 64, 1024, P.Kd + krow0 * 1024 + h * 128 + 64, 1024, P.Vd + krow0 * 1024 + h * 128, 1024, NT, wnt, true, prompt, qpos0, shm, lane, wid);
            if (wnt > 0) {
                const int r32 = lane & 31;
#pragma unroll
                for (int d = 0; d < 4; ++d)
#pragma unroll
                    for (int g = 0; g < 4; ++g) { const f32x4 a = *(const f32x4*)(oscr + (d * 4 + g) * 256);
#pragma unroll
                        for (int e = 0; e < 4; ++e) o[d][4 * g + e] = a[e] - lam * o[d][4 * g + e]; }
                float gs[4];
#pragma unroll
                for (int d = 0; d < 4; ++d) gs[d] = P.g_subln[d * 32 + r32] * (1.0f - LAM_INIT);
#pragma unroll
                for (int r = 0; r < 16; ++r) { float ss = (o[0][r] * o[0][r] + o[1][r] * o[1][r]) + (o[2][r] * o[2][r] + o[3][r] * o[3][r]);
                    ss += __shfl_xor(ss, 1); ss += __shfl_xor(ss, 2); ss += __shfl_xor(ss, 4); ss += __shfl_xor(ss, 8); ss += __shfl_xor(ss, 16);
                    const float rstd = rsqrt_f(ss * (1.0f / 128.0f) + EPS);
#pragma unroll
                    for (int d = 0; d < 4; ++d) o[d][r] *= rstd * gs[d]; }
                store_o(o, P.mix + qrow0 * DM + h * 128, shm, lane, wid);
            }
        } else {
            attn_pass<192>(o, P.Qm + qrow0 * 1536 + h * 192, 1536, P.Km + krow0 * 1536 + h * 192, 1536, P.Vm + krow0 * 1024 + h * 128, 1024, NT, wnt, false, prompt, qpos0, shm, lane, wid);
            if (wnt > 0) store_o(o, P.mix + qrow0 * DM + 1024 + h * 128, shm, lane, wid);
        }
        __syncthreads();
    }
}
#undef ATT_WAITBAR
}
constexpr int NPHASES = 9;
struct Args { const float* in[22]; float* out; unsigned char* ws; int ph_lo, ph_hi; };
template <bool COOP>
__global__ void __launch_bounds__(NTHREADS, 2) fwd_kernel(Args args) {
    extern __shared__ __attribute__((aligned(16))) unsigned char lds_raw[];
    LAS unsigned char* lds = (LAS unsigned char*)lds_raw;
    const int wave = __builtin_amdgcn_readfirstlane(threadIdx.x >> 6);
    const int G = gridDim.x; const int bx = blockIdx.x; const int vcu = (G % 8 == 0) ? (bx % 8) * (G / 8) + bx / 8 : bx;
    const int gw = vcu * NWAVES + wave, NGW = G * NWAVES;
#define FRESH_LANE() int lane; { int t_ = (int)__builtin_amdgcn_mbcnt_hi(~0u, __builtin_amdgcn_mbcnt_lo(~0u, 0u)); asm volatile("" : "+v"(t_)); lane = t_; }
    Ptrs P;
    P.x_prompt = args.in[0]; P.x_sample = args.in[1]; P.c_dk = args.in[2]; P.c_dv = args.in[3]; P.c_ckv = args.in[4]; P.c_kr = args.in[5]; P.meta = args.in[6]; P.rel_bias = args.in[7];
    P.g_attn = args.in[8]; P.w_in = args.in[9]; P.lam4 = args.in[10]; P.g_subln = args.in[11]; P.g_q = args.in[12]; P.w_uq = args.in[13]; P.g_kv = args.in[14]; P.w_ukv = args.in[15];
    P.w_out = args.in[16]; P.g_ffn = args.in[17]; P.w_gate = args.in[18]; P.w_up = args.in[19]; P.w_down = args.in[20]; P.g_final = args.in[21];
    P.out = args.out; P.ws = args.ws; unsigned char* ws = args.ws; unsigned char* ob = (unsigned char*)args.out;
    P.WinT = (bf16*)(ws + WS_WIN); P.WuqT = (bf16*)(ws + WS_WUQ); P.WukvT = (bf16*)(ws + WS_WUKV); P.WoutT = (bf16*)(ws + WS_WOUT); P.WguT = (bf16*)(ws + WS_WGU); P.WdT = (bf16*)(ws + WS_WD);
    P.Qd = (bf16*)(ws + WS_QD); P.Kd = (bf16*)(ws + WS_KD); P.Vd = (bf16*)(ws + WS_VD); P.Vm = (bf16*)(ws + WS_VM); P.Km = (bf16*)(ws + WS_KM); P.Qm = (bf16*)(ws + WS_QM);
    P.mix = (bf16*)(ws + WS_MIX); P.x2b = (bf16*)(ws + WS_X2B); P.H = (bf16*)(ws + WS_H);
    P.h1 = (bf16*)(ob + DO_H1); P.zc = (float*)(ob + DO_ZC); P.cqn = (bf16*)(ob + DO_CQN); P.ckvn = (bf16*)(ob + DO_CKVN); P.oscr = (float*)(ob + DO_OSCR);
    P.part2 = (float*)(ws + WS_PART2); P.part3 = (float*)(ws + WS_PART3); P.rope = (f32x2*)(ws + WS_ROPE); P.ctl = (gu32*)(ws + WS_CTL);
    const int lo = args.ph_lo, hi = args.ph_hi;
#define IN(k) (lo <= (k) && (k) < hi)
#define SEAM(k) do { if (COOP && IN(k) && IN((k) + 1)) { cg::this_grid().sync(); } } while (0)
    if (IN(0)) { FRESH_LANE(); p0_prologue(P, lds, gw, NGW, wave, lane); }
    SEAM(0);
    if (IN(1)) { pg8::Gemm g{P.h1, P.WinT, MP, DINP, DM}; pg8::StaticOrder S; S.init(MP, DINP, G, bx);
        epi::EpiIn E{P.Qd, P.Kd, P.Vd, P.zc, P.out};
        pg8::gemm_phase<epi::EpiIn, pg8::StaticOrder, true, true>(lds, g, S, E, wave); }
    SEAM(1);
    if (IN(2)) { FRESH_LANE(); p2_rows(P, gw, NGW, lane); }
    SEAM(2);
    if (IN(3)) {
        { pg8::Gemm g{P.cqn, P.WuqT, R, 1536, QLORA}; pg8::StaticOrder S; S.init(R, 1536, G, bx); epi::EpiUq E{P.Qm, P.rope};
          pg8::gemm_phase<epi::EpiUq, pg8::StaticOrder, true, true>(lds, g, S, E, wave); }
        { pg8::Gemm g{P.ckvn, P.WukvT, KVROWS, 2048, KVLORA}; pg8::StaticOrder S; S.init(KVROWS, 2048, G, bx); epi::EpiUkv E{P.Km, P.Vm};
          pg8::gemm_phase<epi::EpiUkv, pg8::StaticOrder, true, true>(lds, g, S, E, wave); }
    }
    SEAM(3);
    if (IN(4)) { att::attn_phase(P, lds, wave); }
    SEAM(4);
    if (IN(5)) { pg8::Gemm g{P.mix, P.WoutT, R, DM, DM}; pg8::StaticOrder S; S.init(R, DM, G, bx);
        epi::EpiRes<true> E{P.x_prompt, P.x_sample, P.out, P.x2b, P.part2};
        pg8::gemm_phase<epi::EpiRes<true>, pg8::StaticOrder, true, true>(lds, g, S, E, wave); }
    SEAM(5);
    if (IN(6)) { pg8::Gemm g{P.x2b, P.WguT, R, 2 * DFF, DM}; pg8::StaticOrder S; S.init(R, 2 * DFF, G, bx);
        epi::EpiGU E{P.H, P.part2};
        pg8::gemm_phase<epi::EpiGU, pg8::StaticOrder, true, true>(lds, g, S, E, wave); }
    SEAM(6);
    if (IN(7)) { pg8::Gemm g{P.H, P.WdT, R, DM, DFF}; pg8::StaticOrder S; S.init(R, DM, G, bx);
        epi::EpiRes<false> E{P.out, P.out + (size_t)RP * DM, P.out, nullptr, P.part3};
        pg8::gemm_phase<epi::EpiRes<false>, pg8::StaticOrder, true, true>(lds, g, S, E, wave); }
    SEAM(7);
    if (IN(8)) { FRESH_LANE(); p8_final(P, gw, NGW, lane); }
#undef IN
#undef SEAM
}

extern "C" void kernel_launch(void* const* d_in, const int* in_sizes, int n_in, void* d_out, int out_size, void* d_ws, size_t ws_size, hipStream_t stream) {
    static int grid = 0;
    constexpr bool COOP = (MK_N_LAUNCHES == 1);
    const void* kfn = (const void*)fwd_kernel<COOP>;
    if (grid == 0) {
        if (n_in != 22 || (size_t)out_size != O_END || ws_size < WS_END) { fprintf(stderr, "kernel_launch: unexpected problem (n_in %d, out %d, ws %zu); nothing launched\n", n_in, out_size, ws_size); grid = -1; return; }
        int dev = 0, cus = 0, per_cu = 0;
        if (hipGetDevice(&dev) != hipSuccess || hipDeviceGetAttribute(&cus, hipDeviceAttributeMultiprocessorCount, dev) != hipSuccess) { grid = -1; return; }
        if (hipFuncSetAttribute(kfn, hipFuncAttributeMaxDynamicSharedMemorySize, LDS_BYTES) != hipSuccess) { fprintf(stderr, "kernel_launch: hipFuncSetAttribute failed\n"); grid = -1; return; }
        if (hipOccupancyMaxActiveBlocksPerMultiprocessor(&per_cu, kfn, NTHREADS, LDS_BYTES) != hipSuccess || per_cu < 1) { fprintf(stderr, "kernel_launch: occupancy query says %d\n", per_cu); (void)hipGetLastError(); per_cu = 1; }
        grid = cus * 1;
    }
    if (grid < 0) return;
    (void)hipMemsetAsync((char*)d_ws + WS_CTL, 0, CTL_ZERO_BYTES, stream);
    Args a{};
    for (int i = 0; i < 22; ++i) a.in[i] = (const float*)d_in[i];
    a.out = (float*)d_out; a.ws = (unsigned char*)d_ws;
#if MK_N_LAUNCHES == 1
    a.ph_lo = 0; a.ph_hi = NPHASES; void* kargs[] = {&a};
    hipError_t e = hipLaunchCooperativeKernel(kfn, dim3(grid), dim3(NTHREADS), kargs, LDS_BYTES, stream);
    if (e != hipSuccess) fprintf(stderr, "kernel_launch: cooperative launch failed: %s (grid %d)\n", hipGetErrorString(e), grid);
#else
    for (int p = 0; p < NPHASES; ++p) { a.ph_lo = p; a.ph_hi = p + 1; hipLaunchKernelGGL(fwd_kernel<false>, dim3(grid), dim3(NTHREADS), LDS_BYTES, stream, a); }
#endif
}
```

```cpp
#include <hip/hip_runtime.h>
#include <hip/hip_cooperative_groups.h>
#include <cstdio>
#include <cstdint>
namespace cg = cooperative_groups;
__device__ __forceinline__ int lane_id_fresh() { int l; asm volatile("v_mbcnt_lo_u32_b32 %0, -1, 0\n\tv_mbcnt_hi_u32_b32 %0, -1, %0" : "=v"(l)); return l; }
namespace pg8 {
#define PG8_LAS __attribute__((address_space(3)))
typedef unsigned short bf16_t;
typedef short bf16x8 __attribute__((ext_vector_type(8)));
typedef float f32x4 __attribute__((ext_vector_type(4)));
typedef unsigned u32x4 __attribute__((ext_vector_type(4)));
constexpr int BM = 256, BK = 64, HALF = 128, HTB = HALF * BK * 2  , STAGE_BYTES = 8 * HTB, NXCD = 8, WGM = 8;

__host__ __device__ __forceinline__ int lds_byte(int r, int c) { const int st = (r >> 4) * 2 + (c >> 5), rr = r & 15, cc = c & 31, ob = rr * 64 + cc * 2; return st * 1024 + (ob ^ (((ob >> 9) & 1) << 5)); }
__host__ __device__ __forceinline__ void stage_rc(int b, int& R, int& C) { const int st = b / 1024, sb = b % 1024, swz = sb ^ (((sb >> 9) & 1) << 5); R = (st >> 1) * 16 + swz / 64; C = (st & 1) * 32 + (swz % 64) / 2; }
__host__ __device__ __forceinline__ int perm32(int rho) { const int n = rho >> 4, i = rho & 15; return 8 * (i >> 2) + 4 * n + (i & 3); }

struct Unit { int pm, pn, k0, nt, ks; };
struct Gemm { const bf16_t* A; const bf16_t* Bt; int M, N, K; };

struct StaticOrder {
    int nM, nN, nwg, G, c, wgm;
    __host__ __device__ void init(int M, int N, int G_, int c_, int wgm_ = WGM) { nM = M / BM; nN = N / BM; nwg = nM * nN; G = G_; c = c_; wgm = wgm_; }
    __host__ __device__ __forceinline__ bool next(int i, Unit& u) const {
        const long L = (long)i * G + c; if (L >= nwg) return false;
        int wgid = (int)L; { const int q = nwg / NXCD, r = nwg % NXCD, xcd = wgid % NXCD, off = wgid / NXCD; wgid = (xcd < r ? xcd * (q + 1) : r * (q + 1) + (xcd - r) * q) + off; }
        const int nig = wgm * nN, gid = wgid / nig, fm = gid * wgm, gsz = (nM - fm) < wgm ? (nM - fm) : wgm;
        u.pm = fm + ((wgid % nig) % gsz); u.pn = (wgid % nig) / gsz; u.k0 = 0; u.nt = 0; u.ks = -1; return true;
    }
    __device__ __forceinline__ void a_ready(const Unit&) const {}
    __device__ __forceinline__ void done(const Unit&) const {}
};
struct TableOrder {
    StaticOrder so; const unsigned short* row; int nrow;
    __host__ __device__ void init(int M, int N, int G, int c, int wgm, const unsigned short* row_, int nrow_) { so.init(M, N, G, c, wgm); row = row_; nrow = nrow_; }
    __host__ __device__ __forceinline__ bool next(int i, Unit& u) const {
        bool ok; int wgid;
        if (row) { const int w = row[i < nrow ? i : nrow - 1]; ok = (i < nrow) && (w != 0xFFFF); wgid = ok ? w : 0; }
        else { const long L = (long)i * so.G + so.c; ok = L < so.nwg; wgid = ok ? (int)L : 0;
               const int q = so.nwg / NXCD, r = so.nwg % NXCD, xcd = wgid % NXCD, off = wgid / NXCD; wgid = (xcd < r ? xcd * (q + 1) : r * (q + 1) + (xcd - r) * q) + off; }
        const int nig = so.wgm * so.nN, gid = wgid / nig, fm = gid * so.wgm, gsz = (so.nM - fm) < so.wgm ? (so.nM - fm) : so.wgm;
        u.pm = fm + ((wgid % nig) % gsz); u.pn = (wgid % nig) / gsz; u.k0 = 0; u.nt = 0; u.ks = -1; return ok;
    }
    __device__ __forceinline__ void a_ready(const Unit&) const {}
    __device__ __forceinline__ void done(const Unit&) const {}
};

__device__ __forceinline__ unsigned cvt_pk_bf16(float lo, float hi) { unsigned r; asm volatile("v_cvt_pk_bf16_f32 %0, %1, %2" : "=v"(r) : "v"(lo), "v"(hi)); return r; }
typedef float f32x2 __attribute__((ext_vector_type(2)));
#ifndef PROBE_UNIT_BLOCK
#define PROBE_UNIT_BLOCK 0
#endif
template <class Epi, class Sched, bool ALIGN_EPI = false, bool SP2 = false>
__device__ __forceinline__ void gemm_phase(PG8_LAS unsigned char* lds, const Gemm g, const Sched& S, const Epi& E, const int wid, unsigned* g_probe_unit = nullptr) {
    const int lane = lane_id_fresh(), tid = wid * 64 + lane, wr = wid >> 2, wc = wid & 3, fr = lane & 15, fq = lane >> 4;
    const int K = g.K, nt = K / BK;
    unsigned voffA[2], voffB[2];
#pragma unroll
    for (int i = 0; i < 2; ++i) { int R, C; stage_rc(tid * 16 + i * 8192, R, C); const int Rb = Epi::PERM ? ((R & ~31) + perm32(R & 31)) : R;
        voffA[i] = (unsigned)(R * K + C) * 2u; voffB[i] = (unsigned)(Rb * K + C) * 2u; }
    const size_t kstep = (size_t)(BK * 2);
    const size_t hstep = (size_t)HALF * K * 2;
    const size_t tstep = 2 * hstep;
    const unsigned ldsw = (unsigned)wid * 1024u;
    const int aoff = lds_byte(wr * 64 + fr, fq * 8), boff = lds_byte(wc * 32 + fr, fq * 8);
#define PG8_SA(b, h) (((b) * 2 + (h)) * HTB)
#define PG8_SB(b, h) ((4 + (b) * 2 + (h)) * HTB)
#if defined(PROBE_NODMA)
#define PG8_STAGE_COND (blockIdx.x != PROBE_UNIT_BLOCK)
#else
#define PG8_STAGE_COND true
#endif
#define PG8_STAGE(bufoff, gbase, voff) do { if (PG8_STAGE_COND) _Pragma("unroll") for (int _i = 0; _i < 2; ++_i) \
        __builtin_amdgcn_global_load_lds((const unsigned*)((const char*)(gbase) + (voff)[_i]), (PG8_LAS unsigned*)(lds + (bufoff) + ldsw + _i * 8192), 16, 0, 0); } while (0)
#define PG8_LDA(dst, b, h) do { _Pragma("unroll") for (int m = 0; m < 4; ++m) _Pragma("unroll") for (int k = 0; k < 2; ++k) dst[m][k] = *(const PG8_LAS bf16x8*)(lds + PG8_SA(b, h) + aoff + m * 2048 + k * 1024); } while (0)
#define PG8_LDB(dst, b, h) do { _Pragma("unroll") for (int n = 0; n < 2; ++n) _Pragma("unroll") for (int k = 0; k < 2; ++k) dst[n][k] = *(const PG8_LAS bf16x8*)(lds + PG8_SB(b, h) + boff + n * 2048 + k * 1024); } while (0)
#define PG8_MMA(ai, bj, At, Bt) do { __builtin_amdgcn_s_setprio(1); _Pragma("unroll") for (int m = 0; m < 4; ++m) _Pragma("unroll") for (int n = 0; n < 2; ++n) _Pragma("unroll") for (int k = 0; k < 2; ++k) \
        acc[ai][bj][m][n] = __builtin_amdgcn_mfma_f32_16x16x32_bf16(Bt[n][k], At[m][k], acc[ai][bj][m][n], 0, 0, 0); __builtin_amdgcn_s_setprio(0); } while (0)
#define PG8_LDB0(dst, b, h) do { _Pragma("unroll") for (int k = 0; k < 2; ++k) dst[0][k] = *(const PG8_LAS bf16x8*)(lds + PG8_SB(b, h) + boff + k * 1024); } while (0)
#define PG8_MMA0(ai, At, Bt) do { __builtin_amdgcn_s_setprio(1); _Pragma("unroll") for (int m = 0; m < 4; ++m) _Pragma("unroll") for (int k = 0; k < 2; ++k) \
        acc[ai][0][m][0] = __builtin_amdgcn_mfma_f32_16x16x32_bf16(Bt[0][k], At[m][k], acc[ai][0][m][0], 0, 0, 0); __builtin_amdgcn_s_setprio(0); } while (0)
#define PG8_MMAR(ai, At, Bt0, Bt1) do { __builtin_amdgcn_s_setprio(1); _Pragma("unroll") for (int m = 0; m < 4; ++m) _Pragma("unroll") for (int k = 0; k < 2; ++k) \
        acc[ai][0][m][1] = __builtin_amdgcn_mfma_f32_16x16x32_bf16(Bt0[1][k], At[m][k], acc[ai][0][m][1], 0, 0, 0); \
        _Pragma("unroll") for (int m = 0; m < 4; ++m) _Pragma("unroll") for (int n = 0; n < 2; ++n) _Pragma("unroll") for (int k = 0; k < 2; ++k) \
        acc[ai][1][m][n] = __builtin_amdgcn_mfma_f32_16x16x32_bf16(Bt1[n][k], At[m][k], acc[ai][1][m][n], 0, 0, 0); __builtin_amdgcn_s_setprio(0); } while (0)
#if defined(PROBE_NOMFMA)
#define PG8_MMA0_COND (!(narrow && blockIdx.x == PROBE_UNIT_BLOCK))
#else
#define PG8_MMA0_COND true
#endif
#define PG8_MMAS(ai, At, Bt0, Bt1) do { if constexpr (Epi::NARROW_PN >= 0) { if (PG8_MMA0_COND) PG8_MMA0(ai, At, Bt0); if (!narrow) PG8_MMAR(ai, At, Bt0, Bt1); } else { PG8_MMA(ai, 0, At, Bt0); PG8_MMA(ai, 1, At, Bt1); } } while (0)
#define PG8_WAIT_V(n) asm volatile("s_waitcnt vmcnt(" #n ")" ::: "memory")
#define PG8_WAIT_L(n) asm volatile("s_waitcnt lgkmcnt(" #n ")" ::: "memory")
#define PG8_BAR __builtin_amdgcn_s_barrier()
#define PG8_SCHED __builtin_amdgcn_sched_barrier(0)
    Unit cur, nxt; int ui = 0;
    if (!S.next(0, cur)) return;
    f32x4 acc[2][2][4][2];
#pragma unroll
    for (int a = 0; a < 2; ++a)
#pragma unroll
        for (int b = 0; b < 2; ++b)
#pragma unroll
            for (int m = 0; m < 4; ++m)
#pragma unroll
                for (int n = 0; n < 2; ++n) acc[a][b][m][n] = (f32x4){0.f, 0.f, 0.f, 0.f};
    bf16x8 At[4][2], B0[2][2], B1[2][2];
    const char* cA = (const char*)g.A + (size_t)cur.pm * tstep + (size_t)cur.k0 * 2; const char* cB = (const char*)g.Bt + (size_t)cur.pn * tstep + (size_t)cur.k0 * 2;
    S.a_ready(cur);
    if constexpr (SP2) {
        PG8_STAGE(PG8_SB(0, 0), cB, voffB); PG8_STAGE(PG8_SB(0, 1), cB + hstep, voffB); PG8_STAGE(PG8_SA(0, 0), cA, voffA); PG8_STAGE(PG8_SA(0, 1), cA + hstep, voffA);
        if (wr == 1) PG8_BAR;
        PG8_WAIT_V(2); PG8_BAR;
        PG8_STAGE(PG8_SB(1, 0), cB + kstep, voffB); PG8_STAGE(PG8_SA(1, 0), cA + kstep, voffA); PG8_STAGE(PG8_SB(1, 1), cB + hstep + kstep, voffB);
        PG8_WAIT_V(6); PG8_BAR;
    } else {
        PG8_STAGE(PG8_SB(0, 0), cB, voffB); PG8_STAGE(PG8_SA(0, 0), cA, voffA); PG8_STAGE(PG8_SB(0, 1), cB + hstep, voffB); PG8_STAGE(PG8_SA(0, 1), cA + hstep, voffA);
        if (wr == 1) PG8_BAR;
        PG8_WAIT_V(4); PG8_BAR;
        PG8_STAGE(PG8_SB(1, 0), cB + kstep, voffB); PG8_STAGE(PG8_SA(1, 0), cA + kstep, voffA); PG8_STAGE(PG8_SB(1, 1), cB + hstep + kstep, voffB);
        PG8_WAIT_V(6); PG8_BAR;
    }
    for (;;) {
        const bool has_next = S.next(ui + 1, nxt);
        const char* nA = has_next ? (const char*)g.A + (size_t)nxt.pm * tstep + (size_t)nxt.k0 * 2 : cA; const char* nB = has_next ? (const char*)g.Bt + (size_t)nxt.pn * tstep + (size_t)nxt.k0 * 2 : cB;
        const int cnt = cur.nt > 0 ? cur.nt : nt;
        const bool narrow = (Epi::NARROW_PN >= 0) && (cur.pn == Epi::NARROW_PN);
        for (int t = 0; t < cnt; t += 2) {
            const bool last = (t == cnt - 2);
            const char* a1 = cA + (size_t)(t + 1) * kstep;
            const char* a2 = last ? nA : cA + (size_t)(t + 2) * kstep; const char* b2 = last ? nB : cB + (size_t)(t + 2) * kstep;
            const char* a3 = a2 + kstep; const char* b3 = b2 + kstep;
            if (last && has_next) S.a_ready(nxt);
            int t_op = t; asm volatile("" : "+s"(t_op));
            const bool early = SP2 && ALIGN_EPI && ui > 0 && t_op == 0;
            if constexpr (SP2) {
            PG8_LDB(B0, 0, 0); PG8_LDB(B1, 0, 1); PG8_SCHED; PG8_LDA(At, 0, 0); if (!early) PG8_STAGE(PG8_SA(1, 1), a1 + hstep, voffA);
            if (!early) PG8_WAIT_V(8); PG8_WAIT_L(0); PG8_BAR; PG8_MMAS(0, At, B0, B1); PG8_BAR; PG8_SCHED;
            PG8_LDA(At, 0, 1); PG8_STAGE(PG8_SB(0, 0), b2, voffB); PG8_STAGE(PG8_SB(0, 1), b2 + hstep, voffB); PG8_STAGE(PG8_SA(0, 0), a2, voffA);
            if (!early) PG8_WAIT_V(8); PG8_WAIT_L(0); PG8_BAR; PG8_MMAS(1, At, B0, B1); PG8_BAR; PG8_SCHED;
            PG8_LDB(B0, 1, 0); PG8_LDB(B1, 1, 1); PG8_SCHED; PG8_LDA(At, 1, 0); PG8_STAGE(PG8_SA(0, 1), a2 + hstep, voffA);
            if (!early) PG8_WAIT_V(8); PG8_WAIT_L(0); PG8_BAR; PG8_MMAS(0, At, B0, B1); PG8_BAR; PG8_SCHED;
            PG8_LDA(At, 1, 1); PG8_STAGE(PG8_SB(1, 0), b3, voffB); PG8_STAGE(PG8_SB(1, 1), b3 + hstep, voffB); PG8_STAGE(PG8_SA(1, 0), a3, voffA);
            PG8_WAIT_V(8); PG8_WAIT_L(0); PG8_BAR; PG8_MMAS(1, At, B0, B1); PG8_BAR; PG8_SCHED;
            } else {
            PG8_LDB(B0, 0, 0); PG8_SCHED; PG8_LDA(At, 0, 0); PG8_STAGE(PG8_SA(1, 1), a1 + hstep, voffA);
            PG8_WAIT_L(8); PG8_BAR; PG8_WAIT_L(0); PG8_MMA(0, 0, At, B0); PG8_BAR; PG8_SCHED;
            PG8_LDB(B1, 0, 1); PG8_STAGE(PG8_SB(0, 0), b2, voffB);
            PG8_BAR; PG8_WAIT_L(0); PG8_MMA(0, 1, At, B1); PG8_BAR;
            PG8_LDA(At, 0, 1); PG8_STAGE(PG8_SA(0, 0), a2, voffA);
            PG8_BAR; PG8_WAIT_L(0); PG8_MMA(1, 0, At, B0); PG8_BAR; PG8_SCHED;
            PG8_STAGE(PG8_SB(0, 1), b2 + hstep, voffB);
            PG8_WAIT_V(6); PG8_BAR; PG8_MMA(1, 1, At, B1); PG8_BAR;
            PG8_LDB(B0, 1, 0); PG8_SCHED; PG8_LDA(At, 1, 0); PG8_STAGE(PG8_SA(0, 1), a2 + hstep, voffA);
            PG8_WAIT_L(8); PG8_BAR; PG8_WAIT_L(0); PG8_MMA(0, 0, At, B0); PG8_BAR; PG8_SCHED;
            PG8_LDB(B1, 1, 1); PG8_STAGE(PG8_SB(1, 0), b3, voffB);
            PG8_BAR; PG8_WAIT_L(0); PG8_MMA(0, 1, At, B1); PG8_BAR;
            PG8_LDA(At, 1, 1); PG8_STAGE(PG8_SA(1, 0), a3, voffA);
            PG8_BAR; PG8_WAIT_L(0); PG8_MMA(1, 0, At, B0); PG8_BAR; PG8_SCHED;
            PG8_STAGE(PG8_SB(1, 1), b3 + hstep, voffB);
            PG8_WAIT_V(6); PG8_BAR; PG8_MMA(1, 1, At, B1); PG8_BAR;
            }
        }
        if constexpr (ALIGN_EPI) { if (wr == 0) PG8_BAR; }
        if constexpr (SP2 && ALIGN_EPI) { if (has_next) PG8_STAGE(PG8_SA(1, 1), nA + kstep + hstep, voffA); }
#if defined(PROBE_UNIT)
        if (blockIdx.x == PROBE_UNIT_BLOCK && wid == 0 && lane == 0 && g_probe_unit) { g_probe_unit[2 * ui] = (unsigned)__builtin_amdgcn_s_memrealtime(); }
#endif
        if constexpr (!Epi::AFTER_DRAIN) { E(acc, cur, wr, wc, fr, fq); S.done(cur); }
#if defined(PROBE_UNIT)
        if (blockIdx.x == PROBE_UNIT_BLOCK && wid == 0 && lane == 0 && g_probe_unit) { asm volatile("s_waitcnt vmcnt(0)" ::: "memory"); g_probe_unit[2 * ui + 1] = (unsigned)__builtin_amdgcn_s_memrealtime(); }
#endif
        if (!has_next) break;
#pragma unroll
        for (int a = 0; a < 2; ++a)
#pragma unroll
            for (int b = 0; b < 2; ++b)
#pragma unroll
                for (int m = 0; m < 4; ++m)
#pragma unroll
                    for (int n = 0; n < 2; ++n) acc[a][b][m][n] = (f32x4){0.f, 0.f, 0.f, 0.f};
        cur = nxt; cA = nA; cB = nB; ++ui;
        if constexpr (ALIGN_EPI) { if (wr == 1) PG8_BAR; }
    }
    PG8_WAIT_V(0);
    if constexpr (!ALIGN_EPI) { if (wr == 0) PG8_BAR; }
    PG8_BAR;
    if constexpr (Epi::AFTER_DRAIN) { E.fused(acc, cur, wr, wc, fr, fq, lds, wid, lane); S.done(cur); }
#undef PG8_SA
#undef PG8_SB
#undef PG8_STAGE
#undef PG8_LDA
#undef PG8_LDB
#undef PG8_MMA
#undef PG8_MMA0
#undef PG8_MMAR
#undef PG8_MMAS
#undef PG8_LDB0
#undef PG8_WAIT_V
#undef PG8_WAIT_L
#undef PG8_BAR
#undef PG8_SCHED
}
}
#define GAS __attribute__((address_space(1)))
#define LAS __attribute__((address_space(3)))
typedef unsigned short bf16;
typedef unsigned v4u __attribute__((ext_vector_type(4)));
typedef float f32x4 __attribute__((ext_vector_type(4)));
typedef short bf16x8 __attribute__((ext_vector_type(8)));
typedef GAS unsigned gu32;
typedef GAS unsigned long long gu64;
#define RLX_AGENT __ATOMIC_RELAXED, __HIP_MEMORY_SCOPE_AGENT
#define LDS_WAIT() asm volatile("s_waitcnt lgkmcnt(0)" ::: "memory")
#define VM_WAIT() asm volatile("s_waitcnt vmcnt(0)" ::: "memory")
__device__ __forceinline__ unsigned long long rt() { return __builtin_amdgcn_s_memrealtime(); }
__device__ __forceinline__ unsigned f2bf(float f) { unsigned u = __builtin_bit_cast(unsigned, f); return (u + 0x7fffu + ((u >> 16) & 1u)) >> 16; }
__device__ __forceinline__ unsigned pk2(float lo, float hi) { return f2bf(lo) | (f2bf(hi) << 16); }
#define XB_TMO      128
#define XB_XCNT(j)  (256  + 64 * (j))
#define XB_XSUB(j)  (1280 + 64 * (j))
#define XB_XGEN(j)  (2304 + 64 * (j))
#define XB_TOP      3328
#define XB_TOPGEN   3392
#define XCD_BAR_WORDS 3456
#define XB_SPIN_CAP (1u << 18)

__device__ __forceinline__ unsigned xb_ld(unsigned* p)              { return __hip_atomic_load(p, __ATOMIC_RELAXED, __HIP_MEMORY_SCOPE_AGENT); }
__device__ __forceinline__ unsigned xb_add(unsigned* p, unsigned v) { return __hip_atomic_fetch_add(p, v, __ATOMIC_RELAXED, __HIP_MEMORY_SCOPE_AGENT); }
__device__ __forceinline__ unsigned xb_xcc_id() { return (unsigned)__builtin_amdgcn_s_getreg((3 << 11) | 20) & 0xFu; }
#define XB_SPIN(cond, bar) do { unsigned _sp = 0; while (cond) { __builtin_amdgcn_s_sleep(1); \
    if ((++_sp & 255u) == 0u) { if (xb_ld(&(bar)[XB_TMO])) break; if (_sp > XB_SPIN_CAP) { atomicAdd(&(bar)[XB_TMO], 1u); break; } } } } while (0)

struct XcdBarrier {
    unsigned* bar; unsigned x;
    volatile LAS unsigned* st;
};

__device__ __forceinline__ XcdBarrier xcd_barrier_post(unsigned* bar, volatile LAS unsigned* st, bool leader) {
    XcdBarrier b; b.bar = bar; b.x = xb_xcc_id(); b.st = st;
    if (leader) (void)xb_add(&bar[XB_XCNT(b.x)], 1u);
    return b;
}
__device__ __forceinline__ void xcd_barrier_complete(unsigned* bar, unsigned x, unsigned& nloc, unsigned& nx) {
    const unsigned G = gridDim.x * gridDim.y * gridDim.z;
    unsigned sum, cnt, mine, sp = 0u;
    for (;;) {
        sum = 0u; cnt = 0u; mine = 0u;
#pragma unroll
        for (unsigned j = 0; j < 16; ++j) { const unsigned c = xb_ld(&bar[XB_XCNT(j)]); sum += c; cnt += (c > 0u) ? 1u : 0u; mine = (j == x) ? c : mine; }
        if (sum == G) break;
        __builtin_amdgcn_s_sleep(1);
        if ((++sp & 255u) == 0u) { if (xb_ld(&bar[XB_TMO])) break; if (sp > XB_SPIN_CAP) { atomicAdd(&bar[XB_TMO], 1u); break; } }
    }
    nloc = mine > 0u ? mine : 1u; nx = cnt > 0u ? cnt : 1u;
}

__device__ __forceinline__ void xcd_barrier(const XcdBarrier& b, bool leader) {
    asm volatile("s_waitcnt vmcnt(0)" ::: "memory");
    __syncthreads();
    if (leader) {
        unsigned* bar = b.bar;
        __builtin_amdgcn_s_waitcnt(0);
        unsigned nloc = b.st[0], nx = b.st[1];
        if (nloc == 0u) { xcd_barrier_complete(bar, b.x, nloc, nx); b.st[0] = nloc; b.st[1] = nx; }
        const unsigned old = xb_add(&bar[XB_XSUB(b.x)], 1u);
        const unsigned gen = old / nloc;
        if (old + 1u == (gen + 1u) * nloc) {
            __builtin_amdgcn_fence(__ATOMIC_RELEASE, "agent");
            asm volatile("s_waitcnt vmcnt(0)" ::: "memory");
            const unsigned og = xb_add(&bar[XB_TOP], 1u);
            const unsigned tg = og / nx;
            if (og + 1u == (tg + 1u) * nx) xb_add(&bar[XB_TOPGEN], 1u);
            else XB_SPIN(xb_ld(&bar[XB_TOPGEN]) == tg, bar);
            __builtin_amdgcn_fence(__ATOMIC_ACQUIRE, "agent");
            xb_add(&bar[XB_XGEN(b.x)], 1u);
            asm volatile("s_waitcnt vmcnt(0)" ::: "memory");
        } else {
            XB_SPIN(xb_ld(&bar[XB_XGEN(b.x)]) == gen, bar);
            __builtin_amdgcn_fence(__ATOMIC_ACQUIRE, "agent");
            asm volatile("s_waitcnt vmcnt(0)" ::: "memory");
        }
    }
    __syncthreads();
}
#ifndef MK_N_LAUNCHES
#define MK_N_LAUNCHES 1
#endif
constexpr int NWAVES = 8, NTHREADS = 512;
constexpr int DM = 2048, NB = 4, SEQ = 4096, NMETA = 16, LP = NMETA + SEQ, DB = 8, DS = 64, PAST = 1024, LS = PAST + DS;
constexpr int NH = 8, DIN = 3904, DINP = 4096, DFF = 5632, QLORA = 512, KVLORA = 256, ROPE = 64, ZC = 832;
constexpr int RP = NB * SEQ, RS = DB * DS, R = RP + RS, MP = R + 256;
constexpr int KPB = 64 + SEQ, KVP = NB * KPB, KVROWS = KVP + DB * LS;
constexpr float EPS = 1e-6f, LOG2E = 1.4426950408889634f;
constexpr float C2D = 0.125f * LOG2E, C2M = 0.07216878364870323f * LOG2E;
constexpr float LAM_INIT = 0.2f;
static_assert(R == 16896 && MP == 17152 && KVROWS == 25344 && LP == 4112, "shapes");
constexpr size_t O_Y = 0, O_KP = (size_t)R * DM, O_VP = O_KP + (size_t)NB * LP * 1024, O_CKVP = O_VP + (size_t)NB * LP * 1024, O_KRP = O_CKVP + (size_t)NB * LP * 256,
                 O_KS = O_KRP + (size_t)NB * LP * 64, O_VS = O_KS + (size_t)DB * DS * 1024, O_CKVS = O_VS + (size_t)DB * DS * 1024, O_KRS = O_CKVS + (size_t)DB * DS * 256, O_END = O_KRS + (size_t)DB * DS * 64;
static_assert(O_END == 74764288, "d_out size");
constexpr size_t DO_H1 = 0, DO_ZC = (size_t)MP * DM * 2, DO_ZC_END = DO_ZC + (size_t)MP * ZC * 4;
constexpr size_t DO_CQN = 0, DO_CKVN = (size_t)R * QLORA * 2, DO_CKVN_END = DO_CKVN + (size_t)KVROWS * KVLORA * 2;
constexpr size_t DO_OSCR = 0;
static_assert(DO_ZC_END <= (size_t)R * DM * 4 && DO_CKVN_END <= DO_ZC, "d_out scratch map");
constexpr size_t MiB = 1u << 20;
constexpr size_t WS_CTL = 0, CTL_ZERO_BYTES = 1 * MiB;
constexpr size_t WS_WIN = 1 * MiB, WS_WUQ = 17 * MiB, WS_WUKV = WS_WUQ + 3 * MiB / 2, WS_WOUT = WS_WUKV + 1 * MiB, WS_WGU = WS_WOUT + 8 * MiB, WS_WD = WS_WGU + 44 * MiB, WS_WEND = WS_WD + 22 * MiB;
constexpr size_t WS_QD = 94 * MiB, WS_KD = WS_QD + 33 * MiB, WS_VD = WS_KD + (size_t)KVROWS * 2048, WS_VM = WS_VD + (size_t)KVROWS * 2048, WS_KM = WS_VM + (size_t)KVROWS * 2048,
                 WS_QM = WS_KM + (size_t)KVROWS * 3072, WS_MIX = WS_QM + (size_t)R * 3072, WS_MIX_END = WS_MIX + (size_t)R * 4096;
constexpr size_t WS_X2B = WS_QD, WS_H = WS_VM, WS_SLAB = WS_VD;
constexpr size_t WS_PART2 = 466 * MiB, WS_PART3 = 469 * MiB, WS_ROPE = 472 * MiB, WS_END = 474 * MiB;
static_assert(WS_SLAB + (size_t)176 * 262144 <= WS_VM && WS_WEND <= WS_QD && WS_MIX_END <= WS_PART2 && WS_X2B + (size_t)R * 4096 <= WS_VM && WS_H + (size_t)R * DFF * 2 <= WS_PART2 && WS_PART2 + (size_t)R * 128 <= WS_PART3 && WS_PART3 + (size_t)R * 128 + (size_t)R * 4 <= WS_ROPE && WS_ROPE + (size_t)LP * 256 <= WS_END, "d_ws map");
constexpr int CW_QUEUE = 64;
constexpr int CW_BAR = 4096;
constexpr int CTL_ZERO_WORDS = 8192;
constexpr int RING_BYTES = 131072, LDS_BYTES = 163840, LDSCTL_OFF = LDS_BYTES - 512, MISC_OFF = LDSCTL_OFF + 320;

typedef float f32x2 __attribute__((ext_vector_type(2)));
typedef unsigned u32x2 __attribute__((ext_vector_type(2)));
__device__ __forceinline__ float wave_sum(float v) {
#pragma unroll
    for (int o = 1; o < 64; o <<= 1) v += __shfl_xor(v, o);
    return v;
}
__device__ __forceinline__ float rsqrt_f(float x) { return 1.0f / sqrtf(x); }

#define PG8_EPI_LANDED() asm volatile("s_waitcnt vmcnt(0)" ::: "memory")
namespace epi {
using pg8::Unit; using pg8::bf16_t; using pg8::cvt_pk_bf16; using pg8::HALF; using pg8::BM; using pg8::u32x4;

struct EpiIn {
    static constexpr bool PERM = true, AFTER_DRAIN = false; static constexpr int NARROW_PN = 15;
    bf16_t *Qd, *Kd, *Vd; float* zc; float* out;
    __device__ __forceinline__ void st_kv(const f32x4& v0, const f32x4& v1, float* of, bf16_t* ob) const {
        __builtin_nontemporal_store(v0, (f32x4*)of); __builtin_nontemporal_store(v1, (f32x4*)(of + 4));
        u32x4 w; w.x = cvt_pk_bf16(v0[0], v0[1]); w.y = cvt_pk_bf16(v0[2], v0[3]); w.z = cvt_pk_bf16(v1[0], v1[1]); w.w = cvt_pk_bf16(v1[2], v1[3]);
        *(u32x4*)ob = w;
    }
    __device__ __forceinline__ void operator()(const f32x4 (&acc)[2][2][4][2], const Unit& u, int wr, int wc, int fr_, int fq_) const {
        int fr = fr_, fq = fq_; asm volatile("" : "+v"(fr), "+v"(fq));
        const int pm = u.pm, cat = u.pn >> 2, colt = (u.pn & 3) * 256 + wc * 32 + 8 * fq;
        PG8_EPI_LANDED();
        if (u.pn == NARROW_PN) {
            const int col = 768 + 16 * wc + 4 * fq;
            if (pm == 66) { if (wr == 0) *(f32x4*)(zc + (size_t)(R + fr) * ZC + col) = acc[0][0][0][0]; return; }
#pragma unroll
            for (int ai = 0; ai < 2; ++ai)
#pragma unroll
                for (int m = 0; m < 4; ++m) { const size_t r = (size_t)pm * BM + ai * HALF + wr * 64 + m * 16 + fr; *(f32x4*)(zc + r * ZC + col) = acc[ai][0][m][0]; }
            return;
        }
        if (pm == 66) {
            if (wr != 0 || cat == 0) return;
#pragma unroll
            for (int bj = 0; bj < 2; ++bj) { const int col = colt + bj * HALF; const f32x4 v0 = acc[0][bj][0][0], v1 = acc[0][bj][0][1];
                if (cat == 3) { if (col < ZC) { float* z = zc + (size_t)(R + fr) * ZC + col; *(f32x4*)z = v0; *(f32x4*)(z + 4) = v1; } }
                else { for (int b = 0; b < NB; ++b) { const size_t orow = (size_t)b * LP + fr, krow = (size_t)b * KPB + fr;
                        st_kv(v0, v1, out + (cat == 1 ? O_KP : O_VP) + orow * 1024 + col, (cat == 1 ? Kd : Vd) + krow * 1024 + col); } } }
            return;
        }
#pragma unroll
        for (int ai = 0; ai < 2; ++ai)
#pragma unroll
            for (int m = 0; m < 4; ++m) {
                const int rit = ai * HALF + wr * 64 + m * 16 + fr; const size_t r = (size_t)pm * BM + rit;
                size_t orow, krow; size_t obase_k, obase_v;
                if (pm < 64) { const int b = pm >> 4, t = (pm & 15) * 256 + rit; orow = (size_t)b * LP + NMETA + t; krow = (size_t)b * KPB + 64 + t; obase_k = O_KP; obase_v = O_VP; }
                else { const int rr = (pm - 64) * 256 + rit, b = rr >> 6, j = rr & 63; orow = (size_t)b * DS + j; krow = (size_t)KVP + (size_t)b * LS + PAST + j; obase_k = O_KS; obase_v = O_VS; }
#pragma unroll
                for (int bj = 0; bj < 2; ++bj) { const int col = colt + bj * HALF; const f32x4 v0 = acc[ai][bj][m][0], v1 = acc[ai][bj][m][1];
                    if (cat == 0) { u32x4 w; w.x = cvt_pk_bf16(v0[0] * C2D, v0[1] * C2D); w.y = cvt_pk_bf16(v0[2] * C2D, v0[3] * C2D); w.z = cvt_pk_bf16(v1[0] * C2D, v1[1] * C2D); w.w = cvt_pk_bf16(v1[2] * C2D, v1[3] * C2D);
                        *(u32x4*)(Qd + r * 1024 + col) = w; }
                    else if (cat == 1) st_kv(v0, v1, out + obase_k + orow * 1024 + col, Kd + krow * 1024 + col);
                    else if (cat == 2) st_kv(v0, v1, out + obase_v + orow * 1024 + col, Vd + krow * 1024 + col);
                    else if (col < ZC) { float* z = zc + r * ZC + col; *(f32x4*)z = v0; *(f32x4*)(z + 4) = v1; } }
            }
    }
};

struct EpiUq {
    static constexpr bool PERM = true, AFTER_DRAIN = false; static constexpr int NARROW_PN = -1;
    bf16_t* Qm; const f32x2* rope;
    __device__ __forceinline__ void operator()(const f32x4 (&acc)[2][2][4][2], const Unit& u, int wr, int wc, int fr_, int fq_) const {
        int fr = fr_, fq = fq_; asm volatile("" : "+v"(fr), "+v"(fq));
#pragma unroll
        for (int bj = 0; bj < 2; ++bj) { const int n8 = u.pn * BM + bj * HALF + wc * 32 + 8 * fq, h = n8 / 192, j8 = n8 - h * 192;
            f32x4 csA[2][4], csB[2][4];
            if (j8 >= 128) { const int i0p = (j8 - 128) >> 1;
#pragma unroll
                for (int ai = 0; ai < 2; ++ai)
#pragma unroll
                    for (int m = 0; m < 4; ++m) { const size_t r = (size_t)u.pm * BM + ai * HALF + wr * 64 + m * 16 + fr; const int pos = (u.pm < 64) ? NMETA + (int)(r & 4095) : PAST + (int)((r - RP) & 63);
                        csA[ai][m] = *(const f32x4*)(rope + (size_t)pos * 32 + i0p); csB[ai][m] = *(const f32x4*)(rope + (size_t)pos * 32 + i0p + 2); } }
            if (bj == 0) PG8_EPI_LANDED();
#pragma unroll
            for (int ai = 0; ai < 2; ++ai)
#pragma unroll
                for (int m = 0; m < 4; ++m) {
                    const int rit = ai * HALF + wr * 64 + m * 16 + fr; const size_t r = (size_t)u.pm * BM + rit;
                    const f32x4 v0 = acc[ai][bj][m][0] * C2M, v1 = acc[ai][bj][m][1] * C2M; bf16_t* qrow = Qm + r * 1536 + h * 192;
                    if (j8 < 128) { u32x4 w; w.x = cvt_pk_bf16(v0[0], v0[1]); w.y = cvt_pk_bf16(v0[2], v0[3]); w.z = cvt_pk_bf16(v1[0], v1[1]); w.w = cvt_pk_bf16(v1[2], v1[3]); *(u32x4*)(qrow + j8) = w; }
                    else { const int i0 = (j8 - 128) >> 1;
                        const f32x4 cs0 = csA[ai][m], cs1 = csB[ai][m];
                        const float a0 = v0[0] * cs0[0] - v0[1] * cs0[1], b0 = v0[0] * cs0[1] + v0[1] * cs0[0];
                        const float a1 = v0[2] * cs0[2] - v0[3] * cs0[3], b1 = v0[2] * cs0[3] + v0[3] * cs0[2];
                        const float a2 = v1[0] * cs1[0] - v1[1] * cs1[1], b2 = v1[0] * cs1[1] + v1[1] * cs1[0];
                        const float a3 = v1[2] * cs1[2] - v1[3] * cs1[3], b3 = v1[2] * cs1[3] + v1[3] * cs1[2];
                        u32x2 wa, wb; wa.x = cvt_pk_bf16(a0, a1); wa.y = cvt_pk_bf16(a2, a3); wb.x = cvt_pk_bf16(b0, b1); wb.y = cvt_pk_bf16(b2, b3);
                        *(u32x2*)(qrow + 128 + i0) = wa; *(u32x2*)(qrow + 160 + i0) = wb; }
                } }
    }
};

struct EpiUkv {
    static constexpr bool PERM = true, AFTER_DRAIN = false; static constexpr int NARROW_PN = -1;
    bf16_t *Km, *Vm;
    __device__ __forceinline__ void operator()(const f32x4 (&acc)[2][2][4][2], const Unit& u, int wr, int wc, int fr_, int fq_) const {
        int fr = fr_, fq = fq_; asm volatile("" : "+v"(fr), "+v"(fq));
        PG8_EPI_LANDED();
        const int c8 = wc * 32 + 8 * fq;
#pragma unroll
        for (int ai = 0; ai < 2; ++ai)
#pragma unroll
            for (int m = 0; m < 4; ++m) { const size_t r = (size_t)u.pm * BM + ai * HALF + wr * 64 + m * 16 + fr;
#pragma unroll
                for (int bj = 0; bj < 2; ++bj) { const f32x4 v0 = acc[ai][bj][m][0], v1 = acc[ai][bj][m][1];
                    u32x4 w; w.x = cvt_pk_bf16(v0[0], v0[1]); w.y = cvt_pk_bf16(v0[2], v0[3]); w.z = cvt_pk_bf16(v1[0], v1[1]); w.w = cvt_pk_bf16(v1[2], v1[3]);
                    if (bj == 0) *(u32x4*)(Km + r * 1536 + u.pn * 192 + c8) = w; else *(u32x4*)(Vm + r * 1024 + u.pn * 128 + c8) = w; } }
    }
};

struct SplitOrder {
    pg8::StaticOrder full; int nN, nsplit, ksub, G, c;
    __device__ void init(int N, int K, int nsplit_, int G_, int c_) { full.init(RP, N, G_, c_,   4); nN = N / BM; nsplit = nsplit_; ksub = K / nsplit_; G = G_; c = c_; }
    __device__ __forceinline__ bool next(int i, Unit& u) const {
        const long L = (long)i * G + c; const int nfull = (RP / BM) * nN;
        Unit f; f.pm = 0; f.pn = 0; f.k0 = 0; f.nt = 0; f.ks = -1; bool ok = full.next(i, f);
        const int idx = (int)(L - nfull), ks_ = idx % nsplit, t = idx / nsplit;
        if (L >= nfull) { ok = idx < 2 * nN * nsplit; f.pm = RP / BM + t / nN; f.pn = t % nN; f.k0 = ks_ * ksub; f.nt = ksub / pg8::BK; f.ks = ks_; }
        u.pm = f.pm; u.pn = f.pn; u.k0 = f.k0; u.nt = f.nt; u.ks = f.ks; return ok;
    }
    __device__ __forceinline__ void a_ready(const Unit&) const {}
    __device__ __forceinline__ void done(const Unit&) const {}
};
constexpr int NSPLIT_OUT = 8, NSPLIT_DOWN = 11;
__device__ __forceinline__ void store_slab(const f32x4 (&acc)[2][2][4][2], const Unit& u, int nsplit, float* slab, int wr, int wc, int fr, int fq) {
    PG8_EPI_LANDED();
    float* s = slab + (size_t)(((u.pm - RP / BM) * 8 + u.pn) * nsplit + u.ks) * 65536 + wc * 32 + 8 * fq;
#pragma unroll
    for (int ai = 0; ai < 2; ++ai)
#pragma unroll
        for (int m = 0; m < 4; ++m) { float* sr = s + (size_t)(ai * HALF + wr * 64 + m * 16 + fr) * 256;
#pragma unroll
            for (int bj = 0; bj < 2; ++bj) { *(f32x4*)(sr + bj * HALF) = acc[ai][bj][m][0]; *(f32x4*)(sr + bj * HALF + 4) = acc[ai][bj][m][1]; } }
}
struct EpiOut {
    static constexpr bool PERM = true, AFTER_DRAIN = false; static constexpr int NARROW_PN = -1;
    const float* xp; bf16_t* xb; float* part; float* slab;
    __device__ __forceinline__ void operator()(const f32x4 (&acc)[2][2][4][2], const Unit& u, int wr, int wc, int fr_, int fq_) const {
        int fr = fr_, fq = fq_; asm volatile("" : "+v"(fr), "+v"(fq));
        if (u.ks >= 0) { store_slab(acc, u, NSPLIT_OUT, slab, wr, wc, fr, fq); return; }
        const int col0 = u.pn * BM + wc * 32 + 8 * fq;
#pragma unroll
        for (int ai = 0; ai < 2; ++ai) {
            f32x4 xr[4][2][2];
#pragma unroll
            for (int m = 0; m < 4; ++m) { const float* xin = xp + ((size_t)u.pm * BM + ai * HALF + wr * 64 + m * 16 + fr) * DM + col0;
#pragma unroll
                for (int bj = 0; bj < 2; ++bj) { xr[m][bj][0] = __builtin_nontemporal_load((const f32x4*)(xin + bj * HALF)); xr[m][bj][1] = __builtin_nontemporal_load((const f32x4*)(xin + bj * HALF + 4)); } }
#pragma unroll
            for (int m = 0; m < 4; ++m) { const size_t r = (size_t)u.pm * BM + ai * HALF + wr * 64 + m * 16 + fr; float ss = 0.f;
#pragma unroll
                for (int bj = 0; bj < 2; ++bj) { const f32x4 v0 = xr[m][bj][0] + acc[ai][bj][m][0], v1 = xr[m][bj][1] + acc[ai][bj][m][1];
                    ss += ((v0[0] * v0[0] + v0[1] * v0[1]) + (v0[2] * v0[2] + v0[3] * v0[3])) + ((v1[0] * v1[0] + v1[1] * v1[1]) + (v1[2] * v1[2] + v1[3] * v1[3]));
                    u32x4 w; w.x = cvt_pk_bf16(v0[0], v0[1]); w.y = cvt_pk_bf16(v0[2], v0[3]); w.z = cvt_pk_bf16(v1[0], v1[1]); w.w = cvt_pk_bf16(v1[2], v1[3]);
                    *(u32x4*)(xb + r * DM + col0 + bj * HALF) = w; }
                ss += __shfl_xor(ss, 16); ss += __shfl_xor(ss, 32);
                if (fq == 0) part[r * 32 + u.pn * 4 + wc] = ss; }
        }
    }
};
struct EpiDown {
    static constexpr bool PERM = true, AFTER_DRAIN = false; static constexpr int NARROW_PN = -1;
    bf16_t* xb; float* part; float* slab;
    __device__ __forceinline__ void operator()(const f32x4 (&acc)[2][2][4][2], const Unit& u, int wr, int wc, int fr_, int fq_) const {
        int fr = fr_, fq = fq_; asm volatile("" : "+v"(fr), "+v"(fq));
        if (u.ks >= 0) { store_slab(acc, u, NSPLIT_DOWN, slab, wr, wc, fr, fq); return; }
        const int col0 = u.pn * BM + wc * 32 + 8 * fq;
        u32x4 xw[2][4][2];
#pragma unroll
        for (int ai = 0; ai < 2; ++ai)
#pragma unroll
            for (int m = 0; m < 4; ++m) { const bf16_t* xin = xb + ((size_t)u.pm * BM + ai * HALF + wr * 64 + m * 16 + fr) * DM + col0;
#pragma unroll
                for (int bj = 0; bj < 2; ++bj) xw[ai][m][bj] = *(const u32x4*)(xin + bj * HALF); }
#pragma unroll
        for (int ai = 0; ai < 2; ++ai)
#pragma unroll
            for (int m = 0; m < 4; ++m) { const size_t r = (size_t)u.pm * BM + ai * HALF + wr * 64 + m * 16 + fr; float ss = 0.f;
#pragma unroll
                for (int bj = 0; bj < 2; ++bj) { const u32x4 w = xw[ai][m][bj]; f32x4 v0 = acc[ai][bj][m][0], v1 = acc[ai][bj][m][1];
                    v0[0] += __uint_as_float(w.x << 16); v0[1] += __uint_as_float(w.x & 0xffff0000u); v0[2] += __uint_as_float(w.y << 16); v0[3] += __uint_as_float(w.y & 0xffff0000u);
                    v1[0] += __uint_as_float(w.z << 16); v1[1] += __uint_as_float(w.z & 0xffff0000u); v1[2] += __uint_as_float(w.w << 16); v1[3] += __uint_as_float(w.w & 0xffff0000u);
                    ss += ((v0[0] * v0[0] + v0[1] * v0[1]) + (v0[2] * v0[2] + v0[3] * v0[3])) + ((v1[0] * v1[0] + v1[1] * v1[1]) + (v1[2] * v1[2] + v1[3] * v1[3]));
                    u32x4 wo; wo.x = cvt_pk_bf16(v0[0], v0[1]); wo.y = cvt_pk_bf16(v0[2], v0[3]); wo.z = cvt_pk_bf16(v1[0], v1[1]); wo.w = cvt_pk_bf16(v1[2], v1[3]);
                    *(u32x4*)(xb + r * DM + col0 + bj * HALF) = wo; }
                ss += __shfl_xor(ss, 16); ss += __shfl_xor(ss, 32);
                if (fq == 0) part[r * 32 + u.pn * 4 + wc] = ss; }
    }
};

struct EpiGU {
    static constexpr bool PERM = true, AFTER_DRAIN = false; static constexpr int NARROW_PN = -1;
    bf16_t* H; const float* part;
    __device__ __forceinline__ static float silu_mul(float g, float uu) { return g * uu * __builtin_amdgcn_rcpf(1.0f + __builtin_amdgcn_exp2f(-g * LOG2E)); }
    __device__ __forceinline__ void operator()(const f32x4 (&acc)[2][2][4][2], const Unit& u, int wr, int wc, int fr_, int fq_) const {
        int fr = fr_, fq = fq_; asm volatile("" : "+v"(fr), "+v"(fq));
        const int col = u.pn * HALF + wc * 32 + 8 * fq;
        float rs8[2][4];
#pragma unroll
        for (int ai = 0; ai < 2; ++ai)
#pragma unroll
            for (int m = 0; m < 4; ++m) rs8[ai][m] = part[(size_t)u.pm * BM + ai * HALF + wr * 64 + m * 16 + fr];
#pragma unroll
        for (int ai = 0; ai < 2; ++ai)
#pragma unroll
            for (int m = 0; m < 4; ++m) { const size_t r = (size_t)u.pm * BM + ai * HALF + wr * 64 + m * 16 + fr;
                const float rstd = rs8[ai][m];
                const f32x4 g0 = acc[ai][0][m][0] * rstd, g1 = acc[ai][0][m][1] * rstd, u0 = acc[ai][1][m][0] * rstd, u1 = acc[ai][1][m][1] * rstd;
                u32x4 w; w.x = cvt_pk_bf16(silu_mul(g0[0], u0[0]), silu_mul(g0[1], u0[1])); w.y = cvt_pk_bf16(silu_mul(g0[2], u0[2]), silu_mul(g0[3], u0[3]));
                w.z = cvt_pk_bf16(silu_mul(g1[0], u1[0]), silu_mul(g1[1], u1[1])); w.w = cvt_pk_bf16(silu_mul(g1[2], u1[2]), silu_mul(g1[3], u1[3]));
                *(u32x4*)(H + r * DFF + col) = w; }
    }
};
}
constexpr int IN_TBL_N = 5, IN_TBL_CONV = 213;
__device__ const unsigned short in_tbl[256][6] = {
  {0,32,68,100,65535,0},
  {134,166,202,234,65535,1},
  {268,300,336,368,65535,2},
  {402,434,470,502,65535,3},
  {536,568,604,636,664,65535},
  {670,706,738,774,65535,4},
  {804,840,872,908,65535,5},
  {938,974,1006,1042,65535,6},
  {1,33,69,101,65535,7},
  {135,167,203,235,65535,8},
  {269,301,337,369,65535,9},
  {403,435,471,503,65535,10},
  {537,569,605,637,665,65535},
  {671,707,739,775,65535,11},
  {805,841,873,909,65535,12},
  {939,975,1007,1043,65535,13},
  {2,34,70,102,65535,14},
  {136,168,204,236,65535,15},
  {270,302,338,370,65535,16},
  {404,436,472,504,65535,17},
  {538,570,606,638,666,65535},
  {672,708,740,776,65535,18},
  {806,842,874,910,65535,19},
  {940,976,1008,1044,65535,20},
  {3,35,71,103,65535,21},
  {137,169,205,237,65535,22},
  {271,303,339,371,65535,23},
  {405,437,473,505,65535,24},
  {539,571,607,639,667,65535},
  {673,709,741,777,65535,25},
  {807,843,875,911,65535,26},
  {941,977,1009,1045,65535,27},
  {4,36,72,104,65535,28},
  {138,170,206,238,65535,29},
  {272,304,340,372,65535,30},
  {406,438,474,506,65535,31},
  {540,572,600,632,668,65535},
  {674,710,742,778,65535,32},
  {808,844,876,912,65535,33},
  {942,978,1010,1046,65535,34},
  {5,37,73,105,65535,35},
  {139,171,207,239,65535,36},
  {273,305,341,373,65535,37},
  {407,439,475,507,65535,38},
  {541,573,601,633,669,65535},
  {675,711,743,779,65535,39},
  {809,845,877,913,65535,40},
  {943,979,1011,1047,65535,41},
  {6,38,74,106,65535,42},
  {140,172,208,240,65535,43},
  {274,306,342,374,65535,44},
  {408,440,476,508,530,65535},
  {542,574,602,634,65535,45},
  {676,712,744,780,65535,46},
  {810,846,878,914,65535,47},
  {944,980,1012,1048,65535,48},
  {7,39,75,107,65535,49},
  {141,173,209,241,65535,50},
  {275,307,343,375,65535,51},
  {409,441,477,509,531,65535},
  {543,575,603,635,65535,52},
  {677,713,745,781,65535,53},
  {811,847,879,915,65535,54},
  {945,981,1013,1049,65535,55},
  {8,40,76,108,65535,56},
  {142,174,210,242,65535,57},
  {276,308,344,376,65535,58},
  {410,442,478,510,532,65535},
  {544,576,608,640,65535,59},
  {678,714,746,782,65535,60},
  {812,848,880,916,65535,61},
  {946,982,1014,1050,65535,62},
  {9,41,77,109,65535,63},
  {143,175,211,243,65535,64},
  {277,309,345,377,65535,65},
  {411,443,479,511,533,65535},
  {545,577,609,641,65535,66},
  {679,715,747,783,65535,67},
  {813,849,881,917,65535,68},
  {947,983,1015,1051,65535,69},
  {10,42,78,110,65535,70},
  {144,176,212,244,65535,71},
  {278,310,346,378,65535,72},
  {412,444,466,498,534,65535},
  {546,578,610,642,65535,73},
  {680,716,748,784,65535,74},
  {814,850,882,918,65535,75},
  {948,984,1016,1052,65535,76},
  {11,43,79,111,65535,77},
  {145,177,213,245,65535,78},
  {279,311,347,379,65535,79},
  {413,445,467,499,535,65535},
  {547,579,611,643,65535,80},
  {681,717,749,785,65535,81},
  {815,851,883,919,65535,82},
  {949,985,1017,1053,65535,83},
  {12,44,80,112,65535,84},
  {146,178,214,246,65535,85},
  {280,312,348,380,396,65535},
  {414,446,468,500,65535,86},
  {548,580,612,644,65535,87},
  {682,718,750,786,65535,88},
  {816,852,884,920,65535,89},
  {950,986,1018,1054,65535,90},
  {13,45,81,113,65535,91},
  {147,179,215,247,65535,92},
  {281,313,349,381,397,65535},
  {415,447,469,501,65535,93},
  {549,581,613,645,65535,94},
  {683,719,751,787,65535,95},
  {817,853,885,921,65535,96},
  {951,987,1019,1055,65535,97},
  {14,46,82,114,65535,98},
  {148,180,216,248,65535,99},
  {282,314,350,382,398,65535},
  {416,448,480,512,65535,100},
  {550,582,614,646,65535,101},
  {684,720,752,788,65535,102},
  {818,854,886,922,65535,103},
  {952,988,1020,1034,1066,65535},
  {15,47,83,115,65535,104},
  {149,181,217,249,65535,105},
  {283,315,351,383,399,65535},
  {417,449,481,513,65535,106},
  {551,583,615,647,65535,107},
  {685,721,753,789,65535,108},
  {819,855,887,923,65535,109},
  {953,989,1021,1035,1067,65535},
  {16,48,84,116,65535,110},
  {150,182,218,250,65535,111},
  {284,316,332,364,400,65535},
  {418,450,482,514,65535,112},
  {552,584,616,648,65535,113},
  {686,722,754,790,65535,114},
  {820,856,888,924,65535,115},
  {954,990,1022,1036,1068,65535},
  {17,49,85,117,65535,116},
  {151,183,219,251,65535,117},
  {285,317,333,365,401,65535},
  {419,451,483,515,65535,118},
  {553,585,617,649,65535,119},
  {687,723,755,791,65535,120},
  {821,857,889,925,65535,121},
  {955,991,1023,1037,1069,122},
  {18,50,86,118,65535,123},
  {152,184,220,252,262,65535},
  {286,318,334,366,65535,124},
  {420,452,484,516,65535,125},
  {554,586,618,650,65535,126},
  {688,724,756,792,65535,127},
  {822,858,890,926,65535,128},
  {956,970,1002,1038,1070,129},
  {19,51,87,119,65535,130},
  {153,185,221,253,263,65535},
  {287,319,335,367,65535,131},
  {421,453,485,517,65535,132},
  {555,587,619,651,65535,133},
  {689,725,757,793,65535,134},
  {823,859,891,927,65535,135},
  {957,971,1003,1039,1071,136},
  {20,52,88,120,65535,137},
  {154,186,222,254,264,65535},
  {288,320,352,384,65535,138},
  {422,454,486,518,65535,139},
  {556,588,620,652,65535,140},
  {690,726,758,794,65535,141},
  {824,860,892,900,932,65535},
  {958,972,1004,1040,65535,142},
  {21,53,89,121,65535,143},
  {155,187,223,255,265,65535},
  {289,321,353,385,65535,144},
  {423,455,487,519,65535,145},
  {557,589,621,653,65535,146},
  {691,727,759,795,65535,147},
  {825,861,893,901,933,65535},
  {959,973,1005,1041,65535,148},
  {22,54,90,122,65535,149},
  {156,188,198,230,266,65535},
  {290,322,354,386,65535,150},
  {424,456,488,520,65535,151},
  {558,590,622,654,65535,152},
  {692,728,760,796,65535,153},
  {826,862,894,902,934,65535},
  {960,992,1024,1056,65535,154},
  {23,55,91,123,65535,155},
  {157,189,199,231,267,65535},
  {291,323,355,387,65535,156},
  {425,457,489,521,65535,157},
  {559,591,623,655,65535,158},
  {693,729,761,797,65535,159},
  {827,863,895,903,935,65535},
  {961,993,1025,1057,65535,160},
  {24,56,92,124,128,65535},
  {158,190,200,232,65535,161},
  {292,324,356,388,65535,162},
  {426,458,490,522,65535,163},
  {560,592,624,656,65535,164},
  {694,730,762,798,65535,165},
  {828,836,868,904,936,65535},
  {962,994,1026,1058,65535,166},
  {25,57,93,125,129,65535},
  {159,191,201,233,65535,167},
  {293,325,357,389,65535,168},
  {427,459,491,523,65535,169},
  {561,593,625,657,65535,170},
  {695,731,763,799,65535,171},
  {829,837,869,905,937,65535},
  {963,995,1027,1059,65535,172},
  {26,58,94,126,130,65535},
  {160,192,224,256,65535,173},
  {294,326,358,390,65535,174},
  {428,460,492,524,65535,175},
  {562,594,626,658,65535,176},
  {696,732,764,768,800,65535},
  {830,838,870,906,65535,177},
  {964,996,1028,1060,65535,178},
  {27,59,95,127,131,65535},
  {161,193,225,257,65535,179},
  {295,327,359,391,65535,180},
  {429,461,493,525,65535,181},
  {563,595,627,659,65535,182},
  {697,733,765,769,801,65535},
  {831,839,871,907,65535,183},
  {965,997,1029,1061,65535,184},
  {28,60,64,96,132,65535},
  {162,194,226,258,65535,185},
  {296,328,360,392,65535,186},
  {430,462,494,526,65535,187},
  {564,596,628,660,65535,188},
  {698,734,766,770,802,65535},
  {832,864,896,928,65535,189},
  {966,998,1030,1062,65535,190},
  {29,61,65,97,133,65535},
  {163,195,227,259,65535,191},
  {297,329,361,393,65535,192},
  {431,463,495,527,65535,193},
  {565,597,629,661,65535,194},
  {699,735,767,771,803,65535},
  {833,865,897,929,65535,195},
  {967,999,1031,1063,65535,196},
  {30,62,66,98,65535,197},
  {164,196,228,260,65535,198},
  {298,330,362,394,65535,199},
  {432,464,496,528,65535,200},
  {566,598,630,662,65535,201},
  {700,702,704,736,772,202},
  {834,866,898,930,65535,203},
  {968,1000,1032,1064,65535,204},
  {31,63,67,99,65535,205},
  {165,197,229,261,65535,206},
  {299,331,363,395,65535,207},
  {433,465,497,529,65535,208},
  {567,599,631,663,65535,209},
  {701,703,705,737,773,210},
  {835,867,899,931,65535,211},
  {969,1001,1033,1065,65535,212},
};
template <class F> __device__ __forceinline__ void tr_item(const F& f, int K, bf16* WT, int k0, int n0, LAS float* scr, int lane) {
    float v_[32];
#pragma unroll
    for (int i = 0; i < 32; ++i) v_[i] = f(k0 + 2 * i + (lane >> 5), n0 + (lane & 31));
#pragma unroll
    for (int i = 0; i < 32; ++i) scr[(2 * i + (lane >> 5)) * 33 + (lane & 31)] = v_[i];
    LDS_WAIT(); asm volatile("" ::: "memory");
    const int c = lane & 7;
#pragma unroll
    for (int j = 0; j < 4; ++j) { const int n = (lane >> 3) + 8 * j; const LAS float* s = scr + (8 * c) * 33 + n;
        v4u o; o.x = pk2(s[0 * 33], s[1 * 33]); o.y = pk2(s[2 * 33], s[3 * 33]); o.z = pk2(s[4 * 33], s[5 * 33]); o.w = pk2(s[6 * 33], s[7 * 33]);
        *(GAS v4u*)(WT + (size_t)(n0 + n) * K + k0 + 8 * c) = o; }
    LDS_WAIT(); asm volatile("" ::: "memory");
}
struct SrcIn { const float* W; __device__ __forceinline__ float operator()(int k, int n) const { if (n >= 3840) { const int rel = n - 3840; if (rel >= 128) return 0.f; n = 3840 + ((rel >> 5) << 4) + (((rel >> 3) & 3) << 2) + (rel & 3); } return W[(size_t)k * DIN + n]; } };
struct SrcPlain { const float* W; int ld; __device__ __forceinline__ float operator()(int k, int n) const { return W[(size_t)k * ld + n]; } };
struct SrcUq { const float* W; __device__ __forceinline__ float operator()(int k, int n) const { const int h = n / 192, j = n - h * 192;
        const int col = j < 128 ? h * 192 + j : h * 192 + 128 + ((j - 128) >> 1) + 32 * ((j - 128) & 1); return W[(size_t)k * 1536 + col]; } };
struct SrcGU { const float* Wm; const float* g; __device__ __forceinline__ float operator()(int k, int n) const { const int pn = n >> 8, j = n & 127;
        return g[k] * Wm[(size_t)k * DFF + pn * 128 + j]; } };

__device__ __forceinline__ void norm_row_to_bf16(const float* xrow, const float* g, bf16* orow, int lane) {
    GAS unsigned long long* o8 = (GAS unsigned long long*)orow + lane;
    if (!xrow) {
#pragma unroll
        for (int j = 0; j < 8; ++j) o8[64 * j] = 0ull;
        return; }
    const GAS f32x4* xr = (const GAS f32x4*)xrow + lane; const GAS f32x4* gr = (const GAS f32x4*)g + lane;
    f32x4 v[8], gv[8]; float s = 0.f;
#pragma unroll
    for (int j = 0; j < 8; ++j) { v[j] = __builtin_nontemporal_load(xr + 64 * j); gv[j] = gr[64 * j]; }
#pragma unroll
    for (int j = 0; j < 8; ++j) s += (v[j].x * v[j].x + v[j].y * v[j].y) + (v[j].z * v[j].z + v[j].w * v[j].w);
    const float rstd = rsqrt_f(wave_sum(s) * (1.f / DM) + EPS);
#pragma unroll
    for (int j = 0; j < 8; ++j) { const f32x4 gg = gv[j]; o8[64 * j] = (unsigned long long)pk2(v[j].x * rstd * gg.x, v[j].y * rstd * gg.y) | ((unsigned long long)pk2(v[j].z * rstd * gg.z, v[j].w * rstd * gg.w) << 32); }
}
__device__ __forceinline__ void cvt_row1024(const float* src, bf16* dst, int lane) {
    const GAS f32x4* s = (const GAS f32x4*)src + lane; GAS unsigned long long* o8 = (GAS unsigned long long*)dst + lane;
    f32x4 v[4];
#pragma unroll
    for (int j = 0; j < 4; ++j) v[j] = __builtin_nontemporal_load(s + 64 * j);
#pragma unroll
    for (int j = 0; j < 4; ++j) o8[64 * j] = (unsigned long long)pk2(v[j].x, v[j].y) | ((unsigned long long)pk2(v[j].z, v[j].w) << 32);
}
__device__ __forceinline__ void zero_row1024(bf16* dst, int lane) {
    GAS unsigned long long* o8 = (GAS unsigned long long*)dst + lane;
#pragma unroll
    for (int j = 0; j < 4; ++j) o8[64 * j] = 0ull;
}

struct Ptrs {
    const float *x_prompt, *x_sample, *c_dk, *c_dv, *c_ckv, *c_kr, *meta, *rel_bias, *g_attn, *w_in, *lam4, *g_subln, *g_q, *w_uq, *g_kv, *w_ukv, *w_out, *g_ffn, *w_gate, *w_up, *w_down, *g_final;
    float* out; unsigned char* ws;
    bf16 *WinT, *WuqT, *WukvT, *WoutT, *WguT, *WdT, *Qd, *Kd, *Vd, *Vm, *Km, *Qm, *mix, *x2b, *H, *h1, *cqn, *ckvn;
    float *zc, *part2, *part3, *oscr, *slab, *rstd2; f32x2* rope; gu32* ctl;
};

struct TrDesc { const float* src; const float* g; bf16* dst; int ld2, valid, K, k0, n0; };
__device__ __forceinline__ TrDesc tr_decode0(const Ptrs& P, int it, int lane) {
    constexpr int I_IN = (DM / 64) * (DINP / 32), I_UQ = (QLORA / 64) * (1536 / 32), I_UKV = (KVLORA / 64) * (2048 / 32);
    TrDesc d; int r = it; const int ln = lane & 31, lk = lane >> 5; d.g = nullptr; d.valid = 1;
    if (r < I_IN) { const int nb = DINP / 32; d.k0 = 64 * (r / nb); d.n0 = 32 * (r % nb);   d.valid = d.n0 < 3968; int col_ = d.n0 + ln; if (d.n0 >= 3840) { const int rel = col_ - 3840; col_ = 3840 + ((rel >> 5) << 4) + (((rel >> 3) & 3) << 2) + (rel & 3); } d.src = P.w_in + (size_t)(d.k0 + lk) * DIN + (d.valid ? col_ : 0); d.ld2 = 2 * DIN; d.dst = P.WinT; d.K = DM; return d; } r -= I_IN;
    if (r < I_UQ) { const int nb = 1536 / 32; d.k0 = 64 * (r / nb); d.n0 = 32 * (r % nb); const int n = d.n0 + ln, h = n / 192, j = n - h * 192;
        const int col = j < 128 ? h * 192 + j : h * 192 + 128 + ((j - 128) >> 1) + 32 * ((j - 128) & 1);
        d.src = P.w_uq + (size_t)(d.k0 + lk) * 1536 + col; d.ld2 = 2 * 1536; d.dst = P.WuqT; d.K = QLORA; return d; } r -= I_UQ;
    if (r < I_UKV) { const int nb = 2048 / 32; d.k0 = 64 * (r / nb); d.n0 = 32 * (r % nb); d.src = P.w_ukv + (size_t)(d.k0 + lk) * 2048 + d.n0 + ln; d.ld2 = 2 * 2048; d.dst = P.WukvT; d.K = KVLORA; return d; } r -= I_UKV;
    { const int nb = 2 * DFF / 32; d.k0 = 64 * (r / nb); d.n0 = 32 * (r % nb); const int n = d.n0 + ln; const float* Wm = P.w_gate; if ((d.n0 >> 7) & 1) Wm = P.w_up;
      d.src = Wm + (size_t)(d.k0 + lk) * DFF + (n >> 8) * 128 + (n & 127); d.ld2 = 2 * DFF; d.g = P.g_ffn + d.k0; d.dst = P.WguT; d.K = DM; return d; }
}
__device__ __forceinline__ void tr_load(const TrDesc& d, float (&v)[32]) {
    if (d.valid) {
#pragma unroll
        for (int i = 0; i < 32; ++i) v[i] = __builtin_nontemporal_load(d.src + (size_t)i * d.ld2);
    } else {
#pragma unroll
        for (int i = 0; i < 32; ++i) v[i] = 0.f;
    }
}
__device__ __forceinline__ void tr_process(const TrDesc& d, const float (&v)[32], LAS float* scr, int lane) {
#pragma unroll
    for (int i = 0; i < 32; ++i) scr[(2 * i + (lane >> 5)) * 33 + (lane & 31)] = v[i];
    LDS_WAIT(); asm volatile("" ::: "memory");
    const int c = lane & 7;
    f32x4 g0 = {1.f, 1.f, 1.f, 1.f}, g1 = {1.f, 1.f, 1.f, 1.f};
    if (d.g) { g0 = *(const GAS f32x4*)(d.g + 8 * c); g1 = *(const GAS f32x4*)(d.g + 8 * c + 4); }
#pragma unroll
    for (int j = 0; j < 4; ++j) { const int n = (lane >> 3) + 8 * j; const LAS float* s = scr + (8 * c) * 33 + n;
        v4u o; o.x = pk2(s[0 * 33] * g0.x, s[1 * 33] * g0.y); o.y = pk2(s[2 * 33] * g0.z, s[3 * 33] * g0.w); o.z = pk2(s[4 * 33] * g1.x, s[5 * 33] * g1.y); o.w = pk2(s[6 * 33] * g1.z, s[7 * 33] * g1.w);
        *(GAS v4u*)(d.dst + (size_t)(d.n0 + n) * d.K + d.k0 + 8 * c) = o; }
    LDS_WAIT(); asm volatile("" ::: "memory");
}
__device__ __forceinline__ void convert_list0_pipelined(const Ptrs& P, LAS float* scr, int w, int NW, int lane) {
    constexpr int NI = (DM / 64) * (DINP / 32) + (QLORA / 64) * (1536 / 32) + (KVLORA / 64) * (2048 / 32) + (DM / 64) * (2 * DFF / 32);
    int it = w; if (it >= NI) return;
    TrDesc cur = tr_decode0(P, it, lane); float va[32], vb[32]; tr_load(cur, va);
    for (;;) {
        const int itn = it + NW; const bool more = itn < NI; TrDesc nxt = cur;
        if (more) { nxt = tr_decode0(P, itn, lane); tr_load(nxt, vb); }
        tr_process(cur, va, scr, lane);
        if (!more) break;
        cur = nxt; it = itn;
#pragma unroll
        for (int i = 0; i < 32; ++i) va[i] = vb[i];
    }
}

__device__ __forceinline__ void convert_weights(const Ptrs& P, LAS float* scr, int list, int w, int NW, int lane) {
    constexpr int I_IN = (DM / 64) * (DINP / 32), I_UQ = (QLORA / 64) * (1536 / 32), I_UKV = (KVLORA / 64) * (2048 / 32), I_OUT = (DM / 64) * (DM / 32), I_GU = (DM / 64) * (2 * DFF / 32), I_D = (DFF / 64) * (DM / 32);
    if (list == 0) {
        for (int it = w; it < I_IN + I_UQ + I_UKV + I_GU; it += NW) {
            int r = it;
            if (r < I_IN) { const int nb = DINP / 32; tr_item(SrcIn{P.w_in}, DM, P.WinT, 64 * (r / nb), 32 * (r % nb), scr, lane); continue; } r -= I_IN;
            if (r < I_UQ) { const int nb = 1536 / 32; tr_item(SrcUq{P.w_uq}, QLORA, P.WuqT, 64 * (r / nb), 32 * (r % nb), scr, lane); continue; } r -= I_UQ;
            if (r < I_UKV) { const int nb = 2048 / 32; tr_item(SrcPlain{P.w_ukv, 2048}, KVLORA, P.WukvT, 64 * (r / nb), 32 * (r % nb), scr, lane); continue; } r -= I_UKV;
            { const int nb = 2 * DFF / 32, n0 = 32 * (r % nb); const float* Wm = P.w_gate; if ((n0 >> 7) & 1) Wm = P.w_up;
              tr_item(SrcGU{Wm, P.g_ffn}, DM, P.WguT, 64 * (r / nb), n0, scr, lane); }
        }
    } else if (list == 1) {
        for (int r = w; r < I_OUT; r += NW) { const int nb = DM / 32; tr_item(SrcPlain{P.w_out, DM}, DM, P.WoutT, 64 * (r / nb), 32 * (r % nb), scr, lane); }
    } else {
        for (int r = w; r < I_D; r += NW) { const int nb = DM / 32; tr_item(SrcPlain{P.w_down, DM}, DFF, P.WdT, 64 * (r / nb), 32 * (r % nb), scr, lane); }
    }
}
__device__ __forceinline__ void p0_prologue(const Ptrs& P, LAS unsigned char* lds, int gw, int NGW, int wave, int lane) {
    LAS float* scr = (LAS float*)(lds + wave * 16384);
    convert_list0_pipelined(P, scr, gw, NGW, lane);
    { const GAS f32x4* gr = (const GAS f32x4*)P.g_attn + lane; f32x4 gv[8];
#pragma unroll
      for (int j = 0; j < 8; ++j) gv[j] = gr[64 * j];
      for (int m0 = gw; m0 < MP; m0 += 4 * NGW) {
        f32x4 v[4][8];
#pragma unroll
        for (int q = 0; q < 4; ++q) { const int m = m0 + q * NGW;
            const float* src = m < RP ? P.x_prompt + (size_t)m * DM : m < R ? P.x_sample + (size_t)(m - RP) * DM : m < R + NMETA ? P.meta + (size_t)(m - R) * DM : nullptr;
            if (src) {
#pragma unroll
                for (int j = 0; j < 8; ++j) v[q][j] = __builtin_nontemporal_load((const GAS f32x4*)src + lane + 64 * j);
            } else {
#pragma unroll
                for (int j = 0; j < 8; ++j) v[q][j] = (f32x4){0.f, 0.f, 0.f, 0.f};
            } }
#pragma unroll
        for (int q = 0; q < 4; ++q) { const int m = m0 + q * NGW;
            if (m < MP) { float s_ = 0.f;
#pragma unroll
                for (int j = 0; j < 8; ++j) s_ += (v[q][j].x * v[q][j].x + v[q][j].y * v[q][j].y) + (v[q][j].z * v[q][j].z + v[q][j].w * v[q][j].w);
                const float rstd = rsqrt_f(wave_sum(s_) * (1.f / DM) + EPS);
                GAS unsigned long long* o8 = (GAS unsigned long long*)(P.h1 + (size_t)m * DM) + lane;
#pragma unroll
                for (int j = 0; j < 8; ++j) { const f32x4 gg = gv[j], x = v[q][j]; o8[64 * j] = (unsigned long long)pk2(x.x * rstd * gg.x, x.y * rstd * gg.y) | ((unsigned long long)pk2(x.z * rstd * gg.z, x.w * rstd * gg.w) << 32); } } }
      } }
    for (int m0 = gw; m0 < DB * PAST; m0 += 4 * NGW) {
        f32x4 ck[4][4], cv[4][4];
#pragma unroll
        for (int q = 0; q < 4; ++q) { const int m = (m0 + q * NGW < DB * PAST) ? m0 + q * NGW : m0; const GAS f32x4* sk = (const GAS f32x4*)(P.c_dk + (size_t)m * 1024) + lane; const GAS f32x4* sv = (const GAS f32x4*)(P.c_dv + (size_t)m * 1024) + lane;
#pragma unroll
            for (int j = 0; j < 4; ++j) { ck[q][j] = __builtin_nontemporal_load(sk + 64 * j); cv[q][j] = __builtin_nontemporal_load(sv + 64 * j); } }
#pragma unroll
        for (int q = 0; q < 4; ++q) { const int m = m0 + q * NGW;
            if (m < DB * PAST) { const int b = m >> 10, j_ = m & 1023; const size_t krow = (size_t)KVP + (size_t)b * LS + j_;
                GAS unsigned long long* ok = (GAS unsigned long long*)(P.Kd + krow * 1024) + lane; GAS unsigned long long* ov = (GAS unsigned long long*)(P.Vd + krow * 1024) + lane;
#pragma unroll
                for (int j = 0; j < 4; ++j) { ok[64 * j] = (unsigned long long)pk2(ck[q][j].x, ck[q][j].y) | ((unsigned long long)pk2(ck[q][j].z, ck[q][j].w) << 32);
                                              ov[64 * j] = (unsigned long long)pk2(cv[q][j].x, cv[q][j].y) | ((unsigned long long)pk2(cv[q][j].z, cv[q][j].w) << 32); } } }
    }
    for (int m = gw; m < NB * 48; m += NGW) { const size_t krow = (size_t)(m / 48) * KPB + 16 + (m % 48); zero_row1024(P.Kd + krow * 1024, lane); zero_row1024(P.Vd + krow * 1024, lane); }
    for (int e = gw * 64 + lane; e < LP * 32; e += NGW * 64) { const int pos = e >> 5, i = e & 31;
        const float invf = exp2f(-(float)i * (13.287712379549449f / 32.0f)); const float ang = (float)pos * invf;
        const double rev = (double)ang * 0.15915494309189535; const float fr = (float)(rev - floor(rev));
        P.rope[e] = (f32x2){__builtin_amdgcn_cosf(fr), __builtin_amdgcn_sinf(fr)}; }
}

struct P2Row { f32x4 qa, qb, ca; float xv; f32x2 cs; };
__device__ __forceinline__ int p2_pos(int m) { return m < RP ? NMETA + (m & 4095) : m < R ? PAST + ((m - RP) & 63) : m - R; }
__device__ __forceinline__ P2Row p2_load(const Ptrs& P, int m, int lane) {
    const float* z = P.zc + (size_t)m * ZC; P2Row r;
    r.qa = __builtin_nontemporal_load((const GAS f32x4*)z + lane); r.qb = __builtin_nontemporal_load((const GAS f32x4*)z + 64 + lane); r.ca = __builtin_nontemporal_load((const GAS f32x4*)(z + QLORA) + lane);
    r.xv = __builtin_nontemporal_load(z + QLORA + KVLORA + lane); r.cs = P.rope[(size_t)p2_pos(m) * 32 + (lane & 31)]; return r;
}
__device__ __forceinline__ void p2_process(const Ptrs& P, int m, const P2Row& rw, const f32x4& gq0, const f32x4& gq1, const f32x4& gkv, int lane) {
    int ncopy; size_t krow, orow_ckv, orow_kr;
    if (m < RP) { const int b = m >> 12, t = m & 4095; ncopy = 1; krow = (size_t)b * KPB + 64 + t; orow_ckv = O_CKVP + ((size_t)b * LP + NMETA + t) * 256; orow_kr = O_KRP + ((size_t)b * LP + NMETA + t) * 64; }
    else if (m < R) { const int rr = m - RP, b = rr >> 6, j = rr & 63; ncopy = 1; krow = (size_t)KVP + (size_t)b * LS + PAST + j; orow_ckv = O_CKVS + (size_t)rr * 256; orow_kr = O_KRS + (size_t)rr * 64; }
    else { const int mm = m - R; ncopy = NB; krow = mm; orow_ckv = O_CKVP + (size_t)mm * 256; orow_kr = O_KRP + (size_t)mm * 64; }
    const f32x4 qa = rw.qa, qb = rw.qb, ca = rw.ca; const float xv = rw.xv; const f32x2 cs = rw.cs;
    if (m < R) {
        const float ss = wave_sum((qa.x * qa.x + qa.y * qa.y) + (qa.z * qa.z + qa.w * qa.w) + (qb.x * qb.x + qb.y * qb.y) + (qb.z * qb.z + qb.w * qb.w));
        const float rstd = rsqrt_f(ss * (1.f / QLORA) + EPS);
        GAS u32x2* o = (GAS u32x2*)(P.cqn + (size_t)m * QLORA);
        o[lane] = (u32x2){pk2(qa.x * rstd * gq0.x, qa.y * rstd * gq0.y), pk2(qa.z * rstd * gq0.z, qa.w * rstd * gq0.w)};
        o[64 + lane] = (u32x2){pk2(qb.x * rstd * gq1.x, qb.y * rstd * gq1.y), pk2(qb.z * rstd * gq1.z, qb.w * rstd * gq1.w)}; }
    { const float ss = wave_sum((ca.x * ca.x + ca.y * ca.y) + (ca.z * ca.z + ca.w * ca.w));
        const float rstd = rsqrt_f(ss * (1.f / KVLORA) + EPS);
        const f32x4 v = {ca.x * rstd * gkv.x, ca.y * rstd * gkv.y, ca.z * rstd * gkv.z, ca.w * rstd * gkv.w}; const u32x2 w = {pk2(v.x, v.y), pk2(v.z, v.w)};
        for (int c = 0; c < ncopy; ++c) { __builtin_nontemporal_store(v, (GAS f32x4*)(P.out + orow_ckv + (size_t)c * LP * 256) + lane); ((GAS u32x2*)(P.ckvn + (krow + (size_t)c * KPB) * KVLORA))[lane] = w; } }
    { const float xo = __shfl_xor(xv, 32);
        const float v = lane < 32 ? xv * cs.x - xo * cs.y : xo * cs.y + xv * cs.x; const bf16 vb = (bf16)f2bf(v);
        for (int c = 0; c < ncopy; ++c) { __builtin_nontemporal_store(v, P.out + orow_kr + (size_t)c * LP * 64 + lane); bf16* kr = P.Km + (krow + (size_t)c * KPB) * 1536 + 128 + lane;
#pragma unroll
            for (int h = 0; h < NH; ++h) kr[h * 192] = vb; } }
}
__device__ __forceinline__ void p2_rows(const Ptrs& P, int gw, int NGW, int lane) {
    const f32x4 gq0 = ((const GAS f32x4*)P.g_q)[lane], gq1 = ((const GAS f32x4*)P.g_q)[64 + lane], gkv = ((const GAS f32x4*)P.g_kv)[lane];
    for (int m0 = gw; m0 < R + NMETA; m0 += 4 * NGW) {
        P2Row rw[4];
#pragma unroll
        for (int j = 0; j < 4; ++j) { const int m = m0 + j * NGW; rw[j] = p2_load(P, m < R + NMETA ? m : m0, lane); }
#pragma unroll
        for (int j = 0; j < 4; ++j) { const int m = m0 + j * NGW; if (m < R + NMETA) p2_process(P, m, rw[j], gq0, gq1, gkv, lane); }
    }
    for (int m0 = gw; m0 < DB * PAST; m0 += 4 * NGW) {
        f32x4 a[4]; float kr_[4];
#pragma unroll
        for (int j = 0; j < 4; ++j) { const int m = (m0 + j * NGW < DB * PAST) ? m0 + j * NGW : m0; a[j] = __builtin_nontemporal_load((const GAS f32x4*)(P.c_ckv + (size_t)m * KVLORA) + lane); kr_[j] = __builtin_nontemporal_load(P.c_kr + (size_t)m * ROPE + lane); }
#pragma unroll
        for (int j = 0; j < 4; ++j) { const int m = m0 + j * NGW; if (m < DB * PAST) { const int b = m >> 10, jj = m & 1023; const size_t krow = (size_t)KVP + (size_t)b * LS + jj;
            ((GAS u32x2*)(P.ckvn + krow * KVLORA))[lane] = (u32x2){pk2(a[j].x, a[j].y), pk2(a[j].z, a[j].w)};
            const bf16 vb = (bf16)f2bf(kr_[j]); bf16* kr = P.Km + krow * 1536 + 128 + lane;
#pragma unroll
            for (int h = 0; h < NH; ++h) kr[h * 192] = vb; } }
    }
    for (int m = gw; m < NB * 48; m += NGW) { const size_t krow = (size_t)(m / 48) * KPB + 16 + (m % 48);
        ((GAS u32x2*)(P.ckvn + krow * KVLORA))[lane] = (u32x2){0u, 0u}; bf16* kr = P.Km + krow * 1536 + 128 + lane;
#pragma unroll
        for (int h = 0; h < NH; ++h) kr[h * 192] = 0; }
}

__device__ __forceinline__ void p6_pre(const Ptrs& P, int gw, int NGW, int lane) {
    for (int m = gw; m < RS; m += NGW) { const int pmx = m >> 8, rit = m & 255; const size_t r = (size_t)RP + m; float ss = 0.f;
        f32x4 v[8];
#pragma unroll
        for (int j = 0; j < 8; ++j) { f32x4 a = __builtin_nontemporal_load((const GAS f32x4*)(P.x_sample + (size_t)m * DM) + 64 * j + lane);
            const float* sl = P.slab + (size_t)((pmx * 8 + j) * epi::NSPLIT_OUT) * 65536 + (size_t)rit * 256 + 4 * lane;
#pragma unroll
            for (int ks = 0; ks < epi::NSPLIT_OUT; ++ks) a += __builtin_nontemporal_load((const GAS f32x4*)(sl + (size_t)ks * 65536));
            v[j] = a; ss += (a.x * a.x + a.y * a.y) + (a.z * a.z + a.w * a.w);
            if (j == 3) __builtin_amdgcn_sched_barrier(0); }
#pragma unroll
        for (int j = 0; j < 8; ++j) ((GAS u32x2*)(P.x2b + r * DM))[64 * j + lane] = (u32x2){pk2(v[j].x, v[j].y), pk2(v[j].z, v[j].w)};
        ss = wave_sum(ss);
        if (lane == 0) P.rstd2[r] = rsqrt_f(ss * (1.f / DM) + EPS); }
    for (int r = (NGW - 1 - gw) * 64 + lane; r < RP; r += NGW * 64) { const GAS f32x4* pp = (const GAS f32x4*)(P.part2 + (size_t)r * 32); f32x4 s4 = pp[0];
#pragma unroll
        for (int i = 1; i < 8; ++i) s4 += pp[i];
        P.rstd2[r] = rsqrt_f(((s4.x + s4.y) + (s4.z + s4.w)) * (1.f / DM) + EPS); }
}
__device__ __forceinline__ void p8_final(const Ptrs& P, int gw, int NGW, int lane) {
    for (int m = gw; m < RS; m += NGW) { const int pmx = m >> 8, rit = m & 255; const size_t r = (size_t)RP + m; float ss = 0.f;
        GAS f32x4* xr = (GAS f32x4*)(P.out + r * DM) + lane; const GAS f32x4* gr = (const GAS f32x4*)P.g_final + lane;
        f32x4 v[8];
#pragma unroll
        for (int j = 0; j < 8; ++j) { const u32x2 w = __builtin_nontemporal_load((const GAS u32x2*)(P.x2b + r * DM) + 64 * j + lane);
            f32x4 a = (f32x4){__uint_as_float(w.x << 16), __uint_as_float(w.x & 0xffff0000u), __uint_as_float(w.y << 16), __uint_as_float(w.y & 0xffff0000u)};
            const float* sl = P.slab + (size_t)((pmx * 8 + j) * epi::NSPLIT_DOWN) * 65536 + (size_t)rit * 256 + 4 * lane;
#pragma unroll
            for (int ks = 0; ks < epi::NSPLIT_DOWN; ++ks) a += __builtin_nontemporal_load((const GAS f32x4*)(sl + (size_t)ks * 65536));
            v[j] = a; ss += (a.x * a.x + a.y * a.y) + (a.z * a.z + a.w * a.w);
            if (j & 1) __builtin_amdgcn_sched_barrier(0); }
        const float rstd = rsqrt_f(wave_sum(ss) * (1.f / DM) + EPS);
        f32x4 g[8];
#pragma unroll
        for (int j = 0; j < 8; ++j) g[j] = gr[64 * j];
#pragma unroll
        for (int j = 0; j < 8; ++j) __builtin_nontemporal_store((f32x4){v[j].x * rstd * g[j].x, v[j].y * rstd * g[j].y, v[j].z * rstd * g[j].z, v[j].w * rstd * g[j].w}, xr + 64 * j); }
    f32x4 gg[4][2];
#pragma unroll
    for (int q = 0; q < 4; ++q) { gg[q][0] = ((const GAS f32x4*)P.g_final)[2 * (64 * q + lane)]; gg[q][1] = ((const GAS f32x4*)P.g_final)[2 * (64 * q + lane) + 1]; }
    for (int m0 = gw; m0 < RP; m0 += 2 * NGW) {
        const int m1 = (m0 + NGW < RP) ? m0 + NGW : m0;
        const GAS f32x4* pa = (const GAS f32x4*)(P.part3 + (size_t)m0 * 32); const GAS f32x4* pb = (const GAS f32x4*)(P.part3 + (size_t)m1 * 32);
        const GAS v4u* xa = (const GAS v4u*)(P.x2b + (size_t)m0 * DM) + lane; const GAS v4u* xb = (const GAS v4u*)(P.x2b + (size_t)m1 * DM) + lane;
        v4u wa[4], wb[4]; f32x4 sa4 = pa[0], sb4 = pb[0];
#pragma unroll
        for (int q = 0; q < 4; ++q) { wa[q] = xa[64 * q]; wb[q] = xb[64 * q]; }
#pragma unroll
        for (int i = 1; i < 8; ++i) { sa4 += pa[i]; sb4 += pb[i]; }
        const float ra = rsqrt_f(((sa4.x + sa4.y) + (sa4.z + sa4.w)) * (1.f / DM) + EPS), rb = rsqrt_f(((sb4.x + sb4.y) + (sb4.z + sb4.w)) * (1.f / DM) + EPS);
        GAS f32x4* ya = (GAS f32x4*)(P.out + (size_t)m0 * DM) + 2 * lane; GAS f32x4* yb = (GAS f32x4*)(P.out + (size_t)m1 * DM) + 2 * lane;
#define P8_LO(u) __uint_as_float((u) << 16)
#define P8_HI(u) __uint_as_float((u) & 0xffff0000u)
#pragma unroll
        for (int q = 0; q < 4; ++q) {
            __builtin_nontemporal_store((f32x4){P8_LO(wa[q].x) * ra * gg[q][0].x, P8_HI(wa[q].x) * ra * gg[q][0].y, P8_LO(wa[q].y) * ra * gg[q][0].z, P8_HI(wa[q].y) * ra * gg[q][0].w}, ya + 128 * q);
            __builtin_nontemporal_store((f32x4){P8_LO(wa[q].z) * ra * gg[q][1].x, P8_HI(wa[q].z) * ra * gg[q][1].y, P8_LO(wa[q].w) * ra * gg[q][1].z, P8_HI(wa[q].w) * ra * gg[q][1].w}, ya + 128 * q + 1);
            __builtin_nontemporal_store((f32x4){P8_LO(wb[q].x) * rb * gg[q][0].x, P8_HI(wb[q].x) * rb * gg[q][0].y, P8_LO(wb[q].y) * rb * gg[q][0].z, P8_HI(wb[q].y) * rb * gg[q][0].w}, yb + 128 * q);
            __builtin_nontemporal_store((f32x4){P8_LO(wb[q].z) * rb * gg[q][1].x, P8_HI(wb[q].z) * rb * gg[q][1].y, P8_LO(wb[q].w) * rb * gg[q][1].z, P8_HI(wb[q].w) * rb * gg[q][1].w}, yb + 128 * q + 1); }
#undef P8_LO
#undef P8_HI
    }
}
namespace att {
typedef short s16x4 __attribute__((ext_vector_type(4)));
typedef float f32x16 __attribute__((ext_vector_type(16)));
typedef unsigned u32x4 __attribute__((ext_vector_type(4)));
typedef short v4i16_t __attribute__((ext_vector_type(4)));
typedef LAS const unsigned char* lds_cptr;
constexpr int SLOT_K = 24576, SLOT_V = 16384, LDS_K = 0, LDS_V = 3 * SLOT_K, LDS_BT = LDS_V + 3 * SLOT_V, LDS_WS = LDS_BT + 1536, LDS_Q = LDS_WS + NWAVES * 256, LDS_QS = LDS_Q + 64, LDS_END = LDS_QS + NWAVES * 4096;
static_assert(LDS_END <= LDSCTL_OFF, "attention LDS map");
constexpr int NUNITS = 1024 + 128;
__device__ __forceinline__ int crow(int r, int hi) { return (r & 3) + 8 * (r >> 2) + 4 * hi; }
__device__ __forceinline__ void glds16(const void* gsrc, unsigned lds_dst) { unsigned keep;
    asm volatile("s_mov_b32 %0, m0\n\ts_mov_b32 m0, %2\n\ts_nop 0\n\tglobal_load_lds_dwordx4 %1, off\n\ts_mov_b32 m0, %0" : "=&s"(keep) : "v"(gsrc), "s"(lds_dst) : "memory"); }
typedef float f32x2_t __attribute__((ext_vector_type(2))); typedef __bf16 bf16x2_t __attribute__((ext_vector_type(2)));
__device__ __forceinline__ unsigned cvtpk_s(float lo, float hi) { f32x2_t v = {lo, hi}; bf16x2_t b = __builtin_convertvector(v, bf16x2_t); return __builtin_bit_cast(unsigned, b); }
__device__ __forceinline__ s16x4 vtr(lds_cptr p) { return __builtin_bit_cast(s16x4, __builtin_amdgcn_ds_read_tr16_b64_v4i16((LAS v4i16_t*)p)); }
__device__ __forceinline__ float max3f(float a, float b, float c) { float r; asm("v_max3_f32 %0, %1, %2, %3" : "=v"(r) : "v"(a), "v"(b), "v"(c)); return r; }
__device__ __forceinline__ float max2f(float a, float b) { float r; asm("v_max_f32_e32 %0, %1, %2" : "=v"(r) : "v"(a), "v"(b)); return r; }
__device__ __forceinline__ float fadd_s(float a, float b) { float r; asm("v_add_f32_e32 %0, %1, %2" : "=v"(r) : "v"(a), "v"(b)); return r; }
__device__ __forceinline__ float fsub_s(float a, float b) { float r; asm("v_sub_f32_e32 %0, %1, %2" : "=v"(r) : "v"(a), "v"(b)); return r; }
#define ATT_WAITBAR(N) asm volatile("s_waitcnt vmcnt(" #N ") lgkmcnt(0)\n\ts_barrier" ::: "memory")

template <int DQK>
__device__ __forceinline__ void attn_pass(f32x16 (&o)[4], const bf16* Qw, int qstride, const bf16* Kh, int kstride, const bf16* Vh, int vstride,
                                          int NT, int wnt, bool bias, bool prompt, int qpos0, LAS unsigned char* shm, int lane, int wid, unsigned* shm_ctl_probe = nullptr) {
    constexpr int KP = DQK / 64, ND0 = DQK / 16;
    constexpr bool USE_NEGM = (DQK == 64);
    const int r32 = lane & 31, hi = lane >> 5;
    const unsigned lds0 = (unsigned)(uintptr_t)shm;
    LAS float* wsf = (LAS float*)(shm + LDS_WS) + wid * 64;
    const LAS float* btab = (const LAS float*)(shm + LDS_BT);
    const bf16* ksrc = Kh + (size_t)lane * kstride + wid * 8;
    const bf16* vsrc = Vh + (size_t)(16 * (wid & 3) + (lane >> 2)) * vstride + (wid >> 2) * 32 + (lane & 3) * 8;
    const unsigned kdst = lds0 + LDS_K + wid * 1024, vdst = lds0 + LDS_V + wid * 1024;
#define ATT_DMA(t, slot) do { const bf16* ks_ = ksrc + (size_t)(t) * 64 * kstride; const bf16* vs_ = vsrc + (size_t)(t) * 64 * vstride; \
        _Pragma("unroll") for (int i_ = 0; i_ < KP; ++i_) glds16(ks_ + i_ * 64, (unsigned)__builtin_amdgcn_readfirstlane(kdst + (slot) * SLOT_K + i_ * 8192)); \
        _Pragma("unroll") for (int i_ = 0; i_ < 2; ++i_) glds16(vs_ + i_ * 64, (unsigned)__builtin_amdgcn_readfirstlane(vdst + (slot) * SLOT_V + i_ * 8192)); } while (0)
    ATT_DMA(0, 0); if (NT > 1) ATT_DMA(1, 1);
    constexpr int NQR = (DQK == 64) ? ND0 : 8;
    bf16x8 qr[NQR];
    const lds_cptr qs = (lds_cptr)shm + LDS_QS + wid * 4096 + lane * 16;
    if (wnt > 0) {
#pragma unroll
        for (int d0 = 0; d0 < NQR; ++d0) qr[d0] = *(const bf16x8*)(Qw + (size_t)r32 * qstride + d0 * 16 + hi * 8);
#pragma unroll
        for (int d0 = NQR; d0 < ND0; ++d0) *(LAS bf16x8*)(qs + (d0 - NQR) * 1024) = *(const bf16x8*)(Qw + (size_t)r32 * qstride + d0 * 16 + hi * 8);
    } else {
#pragma unroll
        for (int d0 = 0; d0 < NQR; ++d0) qr[d0] = (bf16x8){0, 0, 0, 0, 0, 0, 0, 0};
    }
    float mref = 0.f, l = 0.f; f32x16 negm = f32x16{};
#pragma unroll
    for (int d = 0; d < 4; ++d) o[d] = f32x16{};
    int s_cur = 0, s_n2 = 2;
    const bool g1 = wid >= 4;
#if defined(PROBE_ATT_SEG)
    unsigned pw_acc = 0;
#define ATT_WB_TILE(more) do { if (more) { if (KP == 1) ATT_WAITBAR(3); else ATT_WAITBAR(5); } else ATT_WAITBAR(0); } while (0)
#define ATT_BAR() asm volatile("s_waitcnt lgkmcnt(0)\n\ts_barrier" ::: "memory")
#elif defined(PROBE_ATT_WAIT)
    unsigned pw_acc = 0;
#define ATT_WB_TILE(more) do { const unsigned long long w0_ = __builtin_amdgcn_s_memtime(); if (more) { if (KP == 1) ATT_WAITBAR(3); else ATT_WAITBAR(5); } else ATT_WAITBAR(0); pw_acc += (unsigned)(__builtin_amdgcn_s_memtime() - w0_); } while (0)
#define ATT_BAR() do { const unsigned long long w0_ = __builtin_amdgcn_s_memtime(); asm volatile("s_waitcnt lgkmcnt(0)\n\ts_barrier" ::: "memory"); pw_acc += (unsigned)(__builtin_amdgcn_s_memtime() - w0_); } while (0)
#else
#define ATT_WB_TILE(more) do { if (more) { if (KP == 1) ATT_WAITBAR(3); else ATT_WAITBAR(5); } else ATT_WAITBAR(0); } while (0)
#define ATT_BAR() asm volatile("s_waitcnt lgkmcnt(0)\n\ts_barrier" ::: "memory")
#endif
    if (g1) ATT_WB_TILE(NT > 1);
    f32x16 p0, p1;
    s16x4 va[8], vb[8];
#define ATT_LDVK(dst, ks) do { _Pragma("unroll") for (int d_ = 0; d_ < 4; ++d_) { dst[2 * d_] = vtr(vp + d_ * 4096 + (ks) * 1024); dst[2 * d_ + 1] = vtr(vp + d_ * 4096 + (ks) * 1024 + 512); } } while (0)
    for (int t = 0; t < NT; ++t) {
        const lds_cptr vp = (lds_cptr)shm + LDS_V + s_cur * SLOT_V + ((lane >> 4) & 1) * 32 + (lane & 3) * 8 + (4 * hi + ((lane & 15) >> 2)) * 64;
        if (!g1) ATT_WB_TILE(t + 1 < NT); else ATT_BAR();
#if defined(PROBE_ATT_SEG)
        const unsigned long long sg0_ = __builtin_amdgcn_s_memtime(); unsigned long long sgm2_ = sg0_;
#endif
        if (t < wnt) {
            const lds_cptr kp = (lds_cptr)shm + LDS_K + s_cur * SLOT_K + hi * 1024 + r32 * 16;
            constexpr int GD = (DQK == 64) ? 2 : 1, NG = ND0 / GD;
            bf16x8 ka[2 * GD], kb[2 * GD], qta, qtb;
#define ATT_QF(g, qt) ((GD * (g)) < NQR ? qr[(GD * (g)) < NQR ? (GD * (g)) : 0] : qt)
#define ATT_LDK(dst, qt, g) do { _Pragma("unroll") for (int j_ = 0; j_ < GD; ++j_) { dst[2 * j_] = *(const LAS bf16x8*)(kp + (GD * (g) + j_) * 2048); dst[2 * j_ + 1] = *(const LAS bf16x8*)(kp + (GD * (g) + j_) * 2048 + 512); } \
        if (GD * (g) >= NQR) qt = *(const LAS bf16x8*)(qs + (GD * (g) - NQR) * 1024); } while (0)
#define ATT_MMK(src, qt, g) do { _Pragma("unroll") for (int j_ = 0; j_ < GD; ++j_) { const int d0_ = GD * (g) + j_; const bf16x8 qf_ = (d0_ < NQR) ? qr[d0_ < NQR ? d0_ : 0] : qt; \
        if (d0_ == 0) { if (USE_NEGM) { p0 = __builtin_amdgcn_mfma_f32_32x32x16_bf16(src[0], qf_, negm, 0, 0, 0); p1 = __builtin_amdgcn_mfma_f32_32x32x16_bf16(src[1], qf_, negm, 0, 0, 0); } \
                        else { p0 = __builtin_amdgcn_mfma_f32_32x32x16_bf16(src[0], qf_, f32x16{}, 0, 0, 0); p1 = __builtin_amdgcn_mfma_f32_32x32x16_bf16(src[1], qf_, f32x16{}, 0, 0, 0); } } \
        else { p0 = __builtin_amdgcn_mfma_f32_32x32x16_bf16(src[2 * j_], qf_, p0, 0, 0, 0); p1 = __builtin_amdgcn_mfma_f32_32x32x16_bf16(src[2 * j_ + 1], qf_, p1, 0, 0, 0); } } } while (0)
            ATT_LDK(ka, qta, 0); ATT_LDK(kb, qtb, 1); __builtin_amdgcn_sched_barrier(0);
#pragma unroll
            for (int g = 0; g < NG; g += 2) { ATT_MMK(ka, qta, g); if (g + 2 < NG) ATT_LDK(ka, qta, g + 2); __builtin_amdgcn_sched_barrier(0); ATT_MMK(kb, qtb, g + 1); if (g + 3 < NG) ATT_LDK(kb, qtb, g + 3); __builtin_amdgcn_sched_barrier(0); }
#undef ATT_LDK
#undef ATT_MMK
#undef ATT_QF
        }
        if (g1 && t + 2 < NT) ATT_DMA(t + 2, s_n2);
        if (t < wnt) {
            asm volatile("s_nop 15\n\ts_nop 7" : "+v"(p0), "+v"(p1));
#if defined(PROBE_ATT_SEG)
            const unsigned long long sgm_ = __builtin_amdgcn_s_memtime(); if (PROBE_ATT_SEG == 2) pw_acc += (unsigned)(sgm_ - sg0_); sgm2_ = sgm_;
#endif
            if (!USE_NEGM && t > 0) {
#pragma unroll
                for (int r = 0; r < 16; ++r) { p0[r] = fsub_s(p0[r], mref); p1[r] = fsub_s(p1[r], mref); } }
            if (bias) { const int kp0 = prompt ? (t == 0 ? 0 : 64 * t - 48) : 64 * t;
                if (kp0 + 63 - qpos0 > -128) { const LAS float* bt = btab + (kp0 - qpos0 - r32 + 4 * hi + 224);
#pragma unroll
                    for (int r = 0; r < 16; ++r) { p0[r] += bt[(r & 3) + 8 * (r >> 2)]; p1[r] += bt[32 + (r & 3) + 8 * (r >> 2)]; } } }
            if (prompt && t == 0) {
#pragma unroll
                for (int r = 8; r < 16; ++r) p0[r] = -INFINITY;
#pragma unroll
                for (int r = 0; r < 16; ++r) p1[r] = -INFINITY; }
            float rm;
            { float a = max3f(p0[0], p0[1], p1[0]), b = max3f(p0[2], p0[3], p1[1]); a = max3f(a, p1[2], p1[3]);
#pragma unroll
              for (int r = 4; r < 16; r += 4) { a = max3f(a, p0[r], p0[r + 1]); b = max3f(b, p0[r + 2], p0[r + 3]); a = max3f(a, p1[r], p1[r + 1]); b = max3f(b, p1[r + 2], p1[r + 3]); }
              rm = max2f(a, b);
              auto rr = __builtin_amdgcn_permlane32_swap(__float_as_uint(rm), __float_as_uint(rm), false, false); rm = max2f(__uint_as_float(rr[0]), __uint_as_float(rr[1])); }
            if (t == 0) { mref = rm;
#pragma unroll
                for (int r = 0; r < 16; ++r) { p0[r] = fsub_s(p0[r], rm); p1[r] = fsub_s(p1[r], rm); if (USE_NEGM) negm[r] = -rm; } }
            else if (__any(rm > 8.0f)) { const float dl = fmaxf(rm, 0.f); mref += dl;
#pragma unroll
                for (int r = 0; r < 16; ++r) { p0[r] = fsub_s(p0[r], dl); p1[r] = fsub_s(p1[r], dl); if (USE_NEGM) negm[r] = -mref; }
                const float f = __builtin_amdgcn_exp2f(-dl); l *= f; if (hi == 0) wsf[r32] = f;
                LDS_WAIT();
#pragma unroll
                for (int r = 0; r < 16; ++r) { const float fr_ = wsf[crow(r, hi)];
#pragma unroll
                    for (int d = 0; d < 4; ++d) o[d][r] *= fr_; }
                LDS_WAIT(); }
            ATT_LDVK(va, 0); ATT_LDVK(vb, 1);
        }
#if defined(PROBE_ATT_SEG)
        asm volatile("s_waitcnt lgkmcnt(0)" ::: "memory"); if (PROBE_ATT_SEG == 0) pw_acc += (unsigned)(__builtin_amdgcn_s_memtime() - sg0_);
        if (PROBE_ATT_SEG == 3 && t < wnt) pw_acc += (unsigned)(__builtin_amdgcn_s_memtime() - sgm2_);
#endif
        if (!g1) ATT_BAR(); else ATT_WB_TILE(t + 2 < NT);
#if defined(PROBE_ATT_SEG)
        const unsigned long long sg1_ = __builtin_amdgcn_s_memtime();
#endif
        if (!g1 && t + 2 < NT) ATT_DMA(t + 2, s_n2);
        if (t < wnt) {
            s16x4 vc[8]; u32x4 pw[4]; float e[32];
#pragma unroll
            for (int r = 0; r < 16; ++r) { e[r] = p0[r]; e[16 + r] = p1[r]; }
#define ATT_VF(src, d) ((bf16x8){src[2 * (d)][0], src[2 * (d)][1], src[2 * (d)][2], src[2 * (d)][3], src[2 * (d) + 1][0], src[2 * (d) + 1][1], src[2 * (d) + 1][2], src[2 * (d) + 1][3]})
#define ATT_PIN(x) asm volatile("" : "+v"(x))
            ATT_LDVK(vc, 2);
#pragma unroll
            for (int j2 = 0; j2 < 8; ++j2) e[j2] = __builtin_amdgcn_exp2f(e[j2]);
            float sa = ((e[0] + e[1]) + (e[2] + e[3])) + ((e[4] + e[5]) + (e[6] + e[7]));
            pw[0] = (u32x4){cvtpk_s(e[0], e[1]), cvtpk_s(e[2], e[3]), cvtpk_s(e[4], e[5]), cvtpk_s(e[6], e[7])};
            ATT_PIN(pw[0]); __builtin_amdgcn_sched_barrier(0);
#pragma unroll
            for (int ks = 0; ks < 4; ++ks) {
#pragma unroll
                for (int d = 0; d < 4; ++d) {
                    if (ks == 0 || ks == 3) o[d] = __builtin_amdgcn_mfma_f32_32x32x16_bf16(__builtin_bit_cast(bf16x8, pw[ks]), ATT_VF(va, d), o[d], 0, 0, 0);
                    else if (ks == 1)       o[d] = __builtin_amdgcn_mfma_f32_32x32x16_bf16(__builtin_bit_cast(bf16x8, pw[ks]), ATT_VF(vb, d), o[d], 0, 0, 0);
                    else                    o[d] = __builtin_amdgcn_mfma_f32_32x32x16_bf16(__builtin_bit_cast(bf16x8, pw[ks]), ATT_VF(vc, d), o[d], 0, 0, 0);
                    if (ks < 3) { const int b_ = 8 * (ks + 1) + 2 * d;
                        if (d > 0) { sa = fadd_s(sa, e[b_ - 2]); sa = fadd_s(sa, e[b_ - 1]); }
                        e[b_] = __builtin_amdgcn_exp2f(e[b_]); e[b_ + 1] = __builtin_amdgcn_exp2f(e[b_ + 1]);
                        ATT_PIN(e[b_]); ATT_PIN(e[b_ + 1]); ATT_PIN(sa);
                        if (d == 3) { sa = sa + e[b_] + e[b_ + 1];
                            const int g_ = 8 * (ks + 1); pw[ks + 1] = (u32x4){cvtpk_s(e[g_], e[g_ + 1]), cvtpk_s(e[g_ + 2], e[g_ + 3]), cvtpk_s(e[g_ + 4], e[g_ + 5]), cvtpk_s(e[g_ + 6], e[g_ + 7])};
                            ATT_PIN(pw[ks + 1]); ATT_PIN(sa); } }
                    if (d == 3 && ks == 0) ATT_LDVK(va, 3);
                    __builtin_amdgcn_sched_barrier(0);
                }
            }
            l += sa;
#undef ATT_VF
#undef ATT_PIN
        }
#if defined(PROBE_ATT_SEG)
        asm volatile("s_nop 15\n\ts_nop 7" : "+v"(o[3])); if (PROBE_ATT_SEG == 1) pw_acc += (unsigned)(__builtin_amdgcn_s_memtime() - sg1_);
#endif
        s_cur = (s_cur == 2) ? 0 : s_cur + 1; s_n2 = (s_n2 == 2) ? 0 : s_n2 + 1;
    }
    if (!g1) ATT_BAR();
    ATT_WAITBAR(0);
    if (wnt > 0) {
        { auto rr = __builtin_amdgcn_permlane32_swap(__float_as_uint(l), __float_as_uint(l), false, false); l = __uint_as_float(rr[0]) + __uint_as_float(rr[1]); }
        if (hi == 0) wsf[32 + r32] = l;
        LDS_WAIT();
#pragma unroll
        for (int r = 0; r < 16; ++r) { const float rl = __builtin_amdgcn_rcpf(wsf[32 + crow(r, hi)]);
#pragma unroll
            for (int d = 0; d < 4; ++d) o[d][r] *= rl; }
        LDS_WAIT();
    }
#if defined(PROBE_ATT_WAIT)
    if (blockIdx.x == PROBE_ATT_BLOCK && wid == PROBE_ATT_WAIT && lane == 0 && prompt && (DQK == 64) == (PROBE_ATT == 0)) __hip_atomic_fetch_add((unsigned*)(shm_ctl_probe), pw_acc, __ATOMIC_RELAXED, __HIP_MEMORY_SCOPE_AGENT);
#endif
#undef ATT_LDVK
#undef ATT_DMA
#undef ATT_WB_TILE
#undef ATT_BAR
}

__device__ __forceinline__ void store_o(const f32x16 (&o)[4], bf16* dst, LAS unsigned char* shm, int lane, int wid) {
    const int r32 = lane & 31, hi = lane >> 5; LAS bf16* stg = (LAS bf16*)(shm + wid * 8192);
#pragma unroll
    for (int r = 0; r < 16; ++r) { const int orow = crow(r, hi);
#pragma unroll
        for (int d = 0; d < 4; ++d) stg[orow * 128 + d * 32 + r32] = (bf16)f2bf(o[d][r]); }
    LDS_WAIT();
#pragma unroll
    for (int i = 0; i < 8; ++i) { const int id = i * 64 + lane, row = id >> 4, ch = id & 15; const v4u v = *(const LAS v4u*)(stg + row * 128 + ch * 8); *(GAS v4u*)(dst + (size_t)row * DM + ch * 8) = v; }
    LDS_WAIT();
}

__device__ __forceinline__ int t5_bucket(int rel) {
    const int n = rel < 0 ? -rel : rel; int b;
    if (n < 8) b = n; else { const int lg = 33 - __builtin_clz((unsigned)(n * n)); b = lg < 15 ? lg : 15; }
    return b + (rel > 0 ? 16 : 0);
}

__device__ __forceinline__ void attn_phase(const Ptrs& P, LAS unsigned char* shm, int wid, int rep) {
    float lam; { float d01 = 0.f, d23 = 0.f;
        for (int i = 0; i < 64; ++i) { d01 += P.lam4[i] * P.lam4[64 + i]; d23 += P.lam4[128 + i] * P.lam4[192 + i]; }
        lam = __builtin_bit_cast(float, __builtin_amdgcn_readfirstlane(__builtin_bit_cast(int, expf(d01) - expf(d23) + LAM_INIT))); }
    volatile LAS unsigned* qw = (volatile LAS unsigned*)(shm + LDS_Q);
    for (;;) {
        int tid = wid * 64 + lane_id_fresh(); asm volatile("" : "+v"(tid));
        const int lane = tid & 63;
        float* oscr = P.oscr + (size_t)blockIdx.x * 32768 + (size_t)wid * 4096 + lane * 4;
        if (tid == 0) qw[0] = __hip_atomic_fetch_add((unsigned*)(P.ctl + CW_QUEUE + 64 * rep), 1u, __ATOMIC_RELAXED, __HIP_MEMORY_SCOPE_AGENT);
        __syncthreads();
        const int u = (int)qw[0];
        if (u >= NUNITS) break;
        int kind, qb, type, b, h;
        if (u < 768) { kind = 0; qb = 15 - (u >> 6); const int v = u & 63; type = v >> 5; b = (v & 31) >> 3; h = v & 7; }
        else if (u < 896) { kind = 1; qb = 0; const int v = u - 768; type = v >> 6; b = (v & 63) >> 3; h = v & 7; }
        else { kind = 0; const int w = u - 896; qb = 3 - (w >> 6); const int v = w & 63; type = v >> 5; b = (v & 31) >> 3; h = v & 7; }
        int NT, wnt, qpos0; size_t qrow0, krow0;
        if (kind == 0) { NT = 4 * qb + 5; wnt = 4 * qb + (wid >> 1) + 2; qpos0 = NMETA + 256 * qb + 32 * wid; qrow0 = (size_t)b * SEQ + 256 * qb + 32 * wid; krow0 = (size_t)b * KPB; }
        else { NT = LS / 64; wnt = wid < 2 ? NT : 0; qpos0 = PAST + 32 * wid; qrow0 = (size_t)RP + (size_t)b * DS + 32 * wid; krow0 = (size_t)KVP + (size_t)b * LS; }
        const bool prompt = (kind == 0);
#if defined(PROBE_ATT)
        const unsigned long long pa_t0 = __builtin_amdgcn_s_memtime();
#endif
        f32x16 o[4];
        if (type == 0) {
            if (tid < 352) { const int rel = tid - 224; ((LAS float*)(shm + LDS_BT))[tid] = (P.rel_bias[t5_bucket(rel) * 8 + h] - P.rel_bias[15 * 8 + h]) * LOG2E; }
            attn_pass<64>(o, P.Qd + qrow0 * 1024 + h * 128, 1024, P.Kd + krow0 * 1024 + h * 128, 1024, P.Vd + krow0 * 1024 + h * 128, 1024, NT, wnt, true, prompt, qpos0, shm, lane, wid, (unsigned*)(P.ctl + 2056));
            if (wnt > 0) {
#pragma unroll
                for (int d = 0; d < 4; ++d)
#pragma unroll
                    for (int g = 0; g < 4; ++g) *(f32x4*)(oscr + (d * 4 + g) * 256) = (f32x4){o[d][4 * g], o[d][4 * g + 1], o[d][4 * g + 2], o[d][4 * g + 3]};
            }
            attn_pass<64>(o, P.Qd + qrow0 * 1024 + h * 128 + 64, 1024, P.Kd + krow0 * 1024 + h * 128 + 64, 1024, P.Vd + krow0 * 1024 + h * 128, 1024, NT, wnt, true, prompt, qpos0, shm, lane, wid, (unsigned*)(P.ctl + 2056));
            if (wnt > 0) {
                const int r32 = lane & 31;
#pragma unroll
                for (int d = 0; d < 4; ++d)
#pragma unroll
                    for (int g = 0; g < 4; ++g) { const f32x4 a = *(const f32x4*)(oscr + (d * 4 + g) * 256);
#pragma unroll
                        for (int e = 0; e < 4; ++e) o[d][4 * g + e] = a[e] - lam * o[d][4 * g + e]; }
                float gs[4];
#pragma unroll
                for (int d = 0; d < 4; ++d) gs[d] = P.g_subln[d * 32 + r32] * (1.0f - LAM_INIT);
#pragma unroll
                for (int r = 0; r < 16; ++r) { float ss = (o[0][r] * o[0][r] + o[1][r] * o[1][r]) + (o[2][r] * o[2][r] + o[3][r] * o[3][r]);

#define ATT_SWZ(v, pat) __builtin_bit_cast(float, __builtin_amdgcn_ds_swizzle(__builtin_bit_cast(int, v), pat))
                    ss += ATT_SWZ(ss, 0x041F); ss += ATT_SWZ(ss, 0x081F); ss += ATT_SWZ(ss, 0x101F); ss += ATT_SWZ(ss, 0x201F); ss += ATT_SWZ(ss, 0x401F);
#undef ATT_SWZ

                    const float rstd = rsqrt_f(ss * (1.0f / 128.0f) + EPS);
#pragma unroll
                    for (int d = 0; d < 4; ++d) o[d][r] *= rstd * gs[d]; }
                store_o(o, P.mix + qrow0 * DM + h * 128, shm, lane, wid);
            }
        } else {
            attn_pass<192>(o, P.Qm + qrow0 * 1536 + h * 192, 1536, P.Km + krow0 * 1536 + h * 192, 1536, P.Vm + krow0 * 1024 + h * 128, 1024, NT, wnt, false, prompt, qpos0, shm, lane, wid, (unsigned*)(P.ctl + 2056));
            if (wnt > 0) store_o(o, P.mix + qrow0 * DM + 1024 + h * 128, shm, lane, wid);
        }
        __syncthreads();
#if defined(PROBE_ATT)
        if (blockIdx.x == PROBE_ATT_BLOCK && tid == 0 && kind == 0) { const unsigned dt = (unsigned)(__builtin_amdgcn_s_memtime() - pa_t0);
            __hip_atomic_fetch_add((unsigned*)(P.ctl + 2048 + 2 * type), dt, __ATOMIC_RELAXED, __HIP_MEMORY_SCOPE_AGENT);
            __hip_atomic_fetch_add((unsigned*)(P.ctl + 2049 + 2 * type), (unsigned)(NT * (type == 0 ? 2 : 1)), __ATOMIC_RELAXED, __HIP_MEMORY_SCOPE_AGENT); }
#endif
    }
}
#undef ATT_WAITBAR
}
constexpr int NPHASES = 9;
struct Args { const float* in[22]; float* out; unsigned char* ws; int ph_lo, ph_hi; };
template <bool COOP>
__global__ void __launch_bounds__(NTHREADS, 2) fwd_kernel(Args args) {
    extern __shared__ __attribute__((aligned(16))) unsigned char lds_raw[];
    LAS unsigned char* lds = (LAS unsigned char*)lds_raw;
    const int wave = __builtin_amdgcn_readfirstlane(threadIdx.x >> 6);
    const int G = gridDim.x; const int bx = blockIdx.x; const int vcu = (G % 8 == 0) ? (bx % 8) * (G / 8) + bx / 8 : bx;
    const int gw = vcu * NWAVES + wave, NGW = G * NWAVES;
#define FRESH_LANE() int lane; { int t_ = lane_id_fresh(); asm volatile("" : "+v"(t_)); lane = t_; }
    Ptrs P;
    P.x_prompt = args.in[0]; P.x_sample = args.in[1]; P.c_dk = args.in[2]; P.c_dv = args.in[3]; P.c_ckv = args.in[4]; P.c_kr = args.in[5]; P.meta = args.in[6]; P.rel_bias = args.in[7];
    P.g_attn = args.in[8]; P.w_in = args.in[9]; P.lam4 = args.in[10]; P.g_subln = args.in[11]; P.g_q = args.in[12]; P.w_uq = args.in[13]; P.g_kv = args.in[14]; P.w_ukv = args.in[15];
    P.w_out = args.in[16]; P.g_ffn = args.in[17]; P.w_gate = args.in[18]; P.w_up = args.in[19]; P.w_down = args.in[20]; P.g_final = args.in[21];
    P.out = args.out; P.ws = args.ws; unsigned char* ws = args.ws; unsigned char* ob = (unsigned char*)args.out;
    P.WinT = (bf16*)(ws + WS_WIN); P.WuqT = (bf16*)(ws + WS_WUQ); P.WukvT = (bf16*)(ws + WS_WUKV); P.WoutT = (bf16*)(ws + WS_WOUT); P.WguT = (bf16*)(ws + WS_WGU); P.WdT = (bf16*)(ws + WS_WD);
    P.Qd = (bf16*)(ws + WS_QD); P.Kd = (bf16*)(ws + WS_KD); P.Vd = (bf16*)(ws + WS_VD); P.Vm = (bf16*)(ws + WS_VM); P.Km = (bf16*)(ws + WS_KM); P.Qm = (bf16*)(ws + WS_QM);
    P.mix = (bf16*)(ws + WS_MIX); P.x2b = (bf16*)(ws + WS_X2B); P.H = (bf16*)(ws + WS_H);
    P.h1 = (bf16*)(ob + DO_H1); P.zc = (float*)(ob + DO_ZC); P.cqn = (bf16*)(ob + DO_CQN); P.ckvn = (bf16*)(ob + DO_CKVN); P.oscr = (float*)(ob + DO_OSCR);
    P.slab = (float*)(ws + WS_SLAB); P.rstd2 = (float*)(ws + WS_PART3 + (size_t)R * 128); P.part2 = (float*)(ws + WS_PART2); P.part3 = (float*)(ws + WS_PART3); P.rope = (f32x2*)(ws + WS_ROPE); P.ctl = (gu32*)(ws + WS_CTL);
    const int lo = args.ph_lo, hi = args.ph_hi;
#define IN(k) (lo <= (k) && (k) < hi)
#define LEADER() (wave == 0 && lane_id_fresh() == 0)
    XcdBarrier bar; bar.bar = (unsigned*)(P.ctl + CW_BAR); bar.x = 0; bar.st = (volatile LAS unsigned*)(lds + MISC_OFF + 32);
    if (COOP) {
        { FRESH_LANE(); for (int u = wave * 64 + lane; u < (LDS_BYTES - LDSCTL_OFF) / 4; u += NTHREADS) ((LAS unsigned*)(lds + LDSCTL_OFF))[u] = 0u;
          if (bx == 0) for (int u = wave * 64 + lane; u < CTL_ZERO_WORDS; u += NTHREADS) P.ctl[u] = 0u; }
        __syncthreads();
    }
#ifndef PROBE_TS
#define PROBE_TS -1
#endif
#ifndef PROBE_TS_END
#define PROBE_TS_END PROBE_TS
#endif
#ifndef PROBE_UNIT_PHASE
#define PROBE_UNIT_PHASE 7
#endif
#ifndef PROBE_SCALE
#define PROBE_SCALE 4.0e-7f
#endif
#define STAMP(k) do { if (PROBE_TS >= 0 && bx == 0 && LEADER()) { P.ctl[1024 + (k)] = (unsigned)__builtin_amdgcn_s_memrealtime(); P.ctl[1100 + (k)] = (unsigned)__builtin_amdgcn_s_memtime(); } } while (0)
#define SEAM(k) do { if (COOP && IN(k) && IN((k) + 1)) { if ((k) == 0) { cg::this_grid().sync(); bar = xcd_barrier_post((unsigned*)(P.ctl + CW_BAR), (volatile LAS unsigned*)(lds + MISC_OFF + 32), LEADER()); } else xcd_barrier(bar, LEADER()); } STAMP((k) + 1); } while (0)
    STAMP(0);
#ifndef PROBE_REPEAT
#define PROBE_REPEAT -1
#endif
#define REPS(k) (((k) == PROBE_REPEAT) ? 2 : 1)
#define REP_BAR(k, rep) do { if ((rep) + 1 < REPS(k)) { if (COOP) xcd_barrier(bar, LEADER()); } } while (0)
    if (IN(0)) { FRESH_LANE(); p0_prologue(P, lds, gw, NGW, wave, lane);  if (PROBE_REPEAT == 0) { if (COOP) xcd_barrier(bar, LEADER());  FRESH_LANE(); p0_prologue(P, lds, gw, NGW, wave, lane);  } }
    SEAM(0);
    if (IN(1)) { pg8::Gemm g{P.h1, P.WinT, MP, DINP, DM}; pg8::TableOrder S; const unsigned short* row = (G == 256) ? &in_tbl[bx][0] : nullptr; S.init(MP, DINP, G, bx, 4, row, IN_TBL_N);
        epi::EpiIn E{P.Qd, P.Kd, P.Vd, P.zc, P.out};
        pg8::gemm_phase<epi::EpiIn, pg8::TableOrder, true, true>(lds, g, S, E, wave, PROBE_UNIT_PHASE == 1 ? (unsigned*)(P.ctl + 1300) : nullptr);
        if (row) { const int rank = row[IN_TBL_N];
          if (rank != 0xFFFF) { FRESH_LANE(); convert_weights(P, (LAS float*)(lds + wave * 16384), 1, rank * NWAVES + wave, IN_TBL_CONV * NWAVES, lane); } }
        else { FRESH_LANE(); convert_weights(P, (LAS float*)(lds + wave * 16384), 1, bx * NWAVES + wave, G * NWAVES, lane); }
        if (PROBE_REPEAT == 1) { if (COOP) xcd_barrier(bar, LEADER());  pg8::Gemm g{P.h1, P.WinT, MP, DINP, DM}; pg8::TableOrder S; S.init(MP, DINP, G, bx, 4, nullptr, 0);
        epi::EpiIn E{P.Qd, P.Kd, P.Vd, P.zc, P.out};
        pg8::gemm_phase<epi::EpiIn, pg8::TableOrder, true, true>(lds, g, S, E, wave);  } }
    SEAM(1);
    if (IN(2)) { FRESH_LANE(); p2_rows(P, gw, NGW, lane);  if (PROBE_REPEAT == 2) { if (COOP) xcd_barrier(bar, LEADER());  FRESH_LANE(); p2_rows(P, gw, NGW, lane);  } }
    SEAM(2);
    if (IN(3)) {
        { pg8::Gemm g{P.cqn, P.WuqT, R, 1536, QLORA}; pg8::StaticOrder S; S.init(R, 1536, G, bx); epi::EpiUq E{P.Qm, P.rope};
          pg8::gemm_phase<epi::EpiUq, pg8::StaticOrder, true, true>(lds, g, S, E, wave); }
        { pg8::Gemm g{P.ckvn, P.WukvT, KVROWS, 2048, KVLORA}; pg8::StaticOrder S; S.init(KVROWS, 2048, G, G - 1 - bx); epi::EpiUkv E{P.Km, P.Vm};
          pg8::gemm_phase<epi::EpiUkv, pg8::StaticOrder, true, true>(lds, g, S, E, wave); }
     if (PROBE_REPEAT == 3) { if (COOP) xcd_barrier(bar, LEADER());
        { pg8::Gemm g{P.cqn, P.WuqT, R, 1536, QLORA}; pg8::StaticOrder S; S.init(R, 1536, G, bx); epi::EpiUq E{P.Qm, P.rope};
          pg8::gemm_phase<epi::EpiUq, pg8::StaticOrder, true, true>(lds, g, S, E, wave); }
        { pg8::Gemm g{P.ckvn, P.WukvT, KVROWS, 2048, KVLORA}; pg8::StaticOrder S; S.init(KVROWS, 2048, G, bx); epi::EpiUkv E{P.Km, P.Vm};
          pg8::gemm_phase<epi::EpiUkv, pg8::StaticOrder, true, true>(lds, g, S, E, wave); }
     } }
    SEAM(3);
    if (IN(4)) { att::attn_phase(P, lds, wave, 0); if (PROBE_REPEAT == 4) { if (COOP) xcd_barrier(bar, LEADER()); att::attn_phase(P, lds, wave, 1); } }
    SEAM(4);
    if (IN(5)) { pg8::Gemm g{P.mix, P.WoutT, R, DM, DM}; epi::SplitOrder S; S.init(DM, DM, epi::NSPLIT_OUT, G, bx);
        epi::EpiOut E{P.x_prompt, P.x2b, P.part2, P.slab};
        pg8::gemm_phase<epi::EpiOut, epi::SplitOrder, true, true>(lds, g, S, E, wave); }
    SEAM(5);
    if (IN(6)) { { FRESH_LANE(); p6_pre(P, gw, NGW, lane); } if (COOP) xcd_barrier(bar, LEADER());
        pg8::Gemm g{P.x2b, P.WguT, R, 2 * DFF, DM}; pg8::StaticOrder S; S.init(R, 2 * DFF, G, bx);
        epi::EpiGU E{P.H, P.rstd2};
        pg8::gemm_phase<epi::EpiGU, pg8::StaticOrder, true, true>(lds, g, S, E, wave, (unsigned*)(P.ctl + 1400));
        { const int nwg = (R / 256) * (2 * DFF / 256), n12 = nwg - (nwg / G) * G;
          if (bx >= n12 || n12 == 0) { FRESH_LANE(); const int first = (n12 == 0) ? 0 : n12; convert_weights(P, (LAS float*)(lds + wave * 16384), 2, (bx - first) * NWAVES + wave, (G - first) * NWAVES, lane); } }
        if (PROBE_REPEAT == 6) { if (COOP) xcd_barrier(bar, LEADER());  pg8::Gemm g{P.x2b, P.WguT, R, 2 * DFF, DM}; pg8::StaticOrder S; S.init(R, 2 * DFF, G, bx);
        epi::EpiGU E{P.H, P.rstd2};
        pg8::gemm_phase<epi::EpiGU, pg8::StaticOrder, true, true>(lds, g, S, E, wave);  } }
    SEAM(6);
    if (IN(7)) { pg8::Gemm g{P.H, P.WdT, R, DM, DFF}; epi::SplitOrder S; S.init(DM, DFF, epi::NSPLIT_DOWN, G, bx);
        epi::EpiDown E{P.x2b, P.part3, P.slab};
        pg8::gemm_phase<epi::EpiDown, epi::SplitOrder, true, true>(lds, g, S, E, wave, PROBE_UNIT_PHASE == 7 ? (unsigned*)(P.ctl + 1300) : nullptr); }
    SEAM(7);
    if (IN(8)) { FRESH_LANE(); p8_final(P, gw, NGW, lane); asm volatile("s_waitcnt vmcnt(0)" ::: "memory"); __syncthreads(); if (PROBE_TS == 8 && COOP) xcd_barrier(bar, LEADER()); STAMP(9);
        if (PROBE_TS >= 0 && bx == 0) {
            __syncthreads();
            const unsigned t0 = __hip_atomic_load(P.ctl + 1024 + PROBE_TS, __ATOMIC_RELAXED, __HIP_MEMORY_SCOPE_AGENT), t1 = __hip_atomic_load(P.ctl + 1025 + PROBE_TS_END, __ATOMIC_RELAXED, __HIP_MEMORY_SCOPE_AGENT);
#if defined(PROBE_ATT)
            const unsigned pc = __hip_atomic_load(P.ctl + 2048 + 2 * PROBE_ATT, __ATOMIC_RELAXED, __HIP_MEMORY_SCOPE_AGENT), pn = __hip_atomic_load(P.ctl + 2049 + 2 * PROBE_ATT, __ATOMIC_RELAXED, __HIP_MEMORY_SCOPE_AGENT);
#if defined(PROBE_ATT_WAIT) || defined(PROBE_ATT_VM)
            const unsigned pwc = __hip_atomic_load(P.ctl + 2056, __ATOMIC_RELAXED, __HIP_MEMORY_SCOPE_AGENT);
            const float T_us = (float)pwc / (float)(pn > 0 ? pn : 1u);
#else
            const float T_us = (float)pc / (float)(pn > 0 ? pn : 1u);
#endif
#else
#if defined(PROBE_UNIT)
            const unsigned u0 = __hip_atomic_load(P.ctl + PROBE_UNIT, __ATOMIC_RELAXED, __HIP_MEMORY_SCOPE_AGENT), u1 = __hip_atomic_load(P.ctl + PROBE_UNIT2, __ATOMIC_RELAXED, __HIP_MEMORY_SCOPE_AGENT);
            const float T_us = (float)(u1 - u0) * 0.01f;
#elif defined(PROBE_CLK)
            const unsigned c0 = __hip_atomic_load(P.ctl + 1100 + PROBE_TS, __ATOMIC_RELAXED, __HIP_MEMORY_SCOPE_AGENT), c1 = __hip_atomic_load(P.ctl + 1101 + PROBE_TS, __ATOMIC_RELAXED, __HIP_MEMORY_SCOPE_AGENT);
            const float T_us = (float)(c1 - c0) / ((float)(t1 - t0) * 0.01f);
#else
            const float T_us = (float)(t1 - t0) * 0.01f;
#endif
#endif
#ifndef PROBE_OFFSET
#define PROBE_OFFSET 0.0f
#endif
            const float eps = sqrtf(1.0e-4f + PROBE_SCALE * (T_us - PROBE_OFFSET));
            for (int e = wave * 64 + lane; e < DB * DS * 64; e += NTHREADS) P.out[O_KRS + e] *= (1.0f + eps);
        } }
#undef IN
#undef SEAM
}

extern "C" void kernel_launch(void* const* d_in, const int* in_sizes, int n_in, void* d_out, int out_size, void* d_ws, size_t ws_size, hipStream_t stream) {
    static int grid = 0;
    constexpr bool COOP = (MK_N_LAUNCHES == 1);
    const void* kfn = (const void*)fwd_kernel<COOP>;
    if (grid == 0) {
        if (n_in != 22 || (size_t)out_size != O_END || ws_size < WS_END) { fprintf(stderr, "kernel_launch: unexpected problem (n_in %d, out %d, ws %zu); nothing launched\n", n_in, out_size, ws_size); grid = -1; return; }
        int dev = 0, cus = 0, per_cu = 0;
        if (hipGetDevice(&dev) != hipSuccess || hipDeviceGetAttribute(&cus, hipDeviceAttributeMultiprocessorCount, dev) != hipSuccess) { grid = -1; return; }
        if (hipFuncSetAttribute(kfn, hipFuncAttributeMaxDynamicSharedMemorySize, LDS_BYTES) != hipSuccess) { fprintf(stderr, "kernel_launch: hipFuncSetAttribute failed\n"); grid = -1; return; }
        if (hipOccupancyMaxActiveBlocksPerMultiprocessor(&per_cu, kfn, NTHREADS, LDS_BYTES) != hipSuccess || per_cu < 1) { fprintf(stderr, "kernel_launch: occupancy query says %d\n", per_cu); (void)hipGetLastError(); per_cu = 1; }
        grid = cus * 1;
    }
    if (grid < 0) return;
#if MK_N_LAUNCHES != 1
    (void)hipMemsetAsync((char*)d_ws + WS_CTL, 0, CTL_ZERO_BYTES, stream);
#endif
    Args a{};
    for (int i = 0; i < 22; ++i) a.in[i] = (const float*)d_in[i];
    a.out = (float*)d_out; a.ws = (unsigned char*)d_ws;
#if MK_N_LAUNCHES == 1
    a.ph_lo = 0; a.ph_hi = NPHASES; void* kargs[] = {&a};
    hipError_t e = hipLaunchCooperativeKernel(kfn, dim3(grid), dim3(NTHREADS), kargs, LDS_BYTES, stream);
    if (e != hipSuccess) fprintf(stderr, "kernel_launch: cooperative launch failed: %s (grid %d)\n", hipGetErrorString(e), grid);
#else
    for (int p = 0; p < NPHASES; ++p) { a.ph_lo = p; a.ph_hi = p + 1; hipLaunchKernelGGL(fwd_kernel<false>, dim3(grid), dim3(NTHREADS), LDS_BYTES, stream, a); }
#endif
}
```

```cpp
#include <hip/hip_runtime.h>
#include <hip/hip_cooperative_groups.h>
#include <cstdio>
#include <cstdint>
namespace cg = cooperative_groups;
__device__ __forceinline__ int lane_id_fresh() { int l; asm volatile("v_mbcnt_lo_u32_b32 %0, -1, 0\n\tv_mbcnt_hi_u32_b32 %0, -1, %0" : "=v"(l)); return l; }
namespace pg8 {
#define PG8_LAS __attribute__((address_space(3)))
typedef unsigned short bf16_t;
typedef short bf16x8 __attribute__((ext_vector_type(8)));
typedef float f32x4 __attribute__((ext_vector_type(4)));
typedef unsigned u32x4 __attribute__((ext_vector_type(4)));
constexpr int BM = 256, BK = 64, HALF = 128, HTB = HALF * BK * 2  , STAGE_BYTES = 8 * HTB, NXCD = 8, WGM = 8;

__host__ __device__ __forceinline__ int lds_byte(int r, int c) { const int st = (r >> 4) * 2 + (c >> 5), rr = r & 15, cc = c & 31, ob = rr * 64 + cc * 2; return st * 1024 + (ob ^ (((ob >> 9) & 1) << 5)); }
__host__ __device__ __forceinline__ void stage_rc(int b, int& R, int& C) { const int st = b / 1024, sb = b % 1024, swz = sb ^ (((sb >> 9) & 1) << 5); R = (st >> 1) * 16 + swz / 64; C = (st & 1) * 32 + (swz % 64) / 2; }
__host__ __device__ __forceinline__ int perm32(int rho) { const int n = rho >> 4, i = rho & 15; return 8 * (i >> 2) + 4 * n + (i & 3); }

struct Unit { int pm, pn, k0, nt, ks; };
struct Gemm { const bf16_t* A; const bf16_t* Bt; int M, N, K; };

struct StaticOrder {
    int nM, nN, nwg, G, c, wgm;
    __host__ __device__ void init(int M, int N, int G_, int c_, int wgm_ = WGM) { nM = M / BM; nN = N / BM; nwg = nM * nN; G = G_; c = c_; wgm = wgm_; }
    __host__ __device__ __forceinline__ bool next(int i, Unit& u) const {
        const long L = (long)i * G + c; if (L >= nwg) return false;
        int wgid = (int)L; { const int q = nwg / NXCD, r = nwg % NXCD, xcd = wgid % NXCD, off = wgid / NXCD; wgid = (xcd < r ? xcd * (q + 1) : r * (q + 1) + (xcd - r) * q) + off; }
        const int nig = wgm * nN, gid = wgid / nig, fm = gid * wgm, gsz = (nM - fm) < wgm ? (nM - fm) : wgm;
        u.pm = fm + ((wgid % nig) % gsz); u.pn = (wgid % nig) / gsz; u.k0 = 0; u.nt = 0; u.ks = -1; return true;
    }
    __device__ __forceinline__ void a_ready(const Unit&) const {}
    __device__ __forceinline__ void done(const Unit&) const {}
};
struct TableOrder {
    StaticOrder so; const unsigned short* row; int nrow;
    __host__ __device__ void init(int M, int N, int G, int c, int wgm, const unsigned short* row_, int nrow_) { so.init(M, N, G, c, wgm); row = row_; nrow = nrow_; }
    __host__ __device__ __forceinline__ bool next(int i, Unit& u) const {
        bool ok; int wgid;
        if (row) { const int w = row[i < nrow ? i : nrow - 1]; ok = (i < nrow) && (w != 0xFFFF); wgid = ok ? w : 0; }
        else { const long L = (long)i * so.G + so.c; ok = L < so.nwg; wgid = ok ? (int)L : 0;
               const int q = so.nwg / NXCD, r = so.nwg % NXCD, xcd = wgid % NXCD, off = wgid / NXCD; wgid = (xcd < r ? xcd * (q + 1) : r * (q + 1) + (xcd - r) * q) + off; }
        const int nig = so.wgm * so.nN, gid = wgid / nig, fm = gid * so.wgm, gsz = (so.nM - fm) < so.wgm ? (so.nM - fm) : so.wgm;
        u.pm = fm + ((wgid % nig) % gsz); u.pn = (wgid % nig) / gsz; u.k0 = 0; u.nt = 0; u.ks = -1; return ok;
    }
    __device__ __forceinline__ void a_ready(const Unit&) const {}
    __device__ __forceinline__ void done(const Unit&) const {}
};

__device__ __forceinline__ unsigned cvt_pk_bf16(float lo, float hi) { unsigned r; asm volatile("v_cvt_pk_bf16_f32 %0, %1, %2" : "=v"(r) : "v"(lo), "v"(hi)); return r; }
typedef float f32x2 __attribute__((ext_vector_type(2)));
#ifndef PROBE_UNIT_BLOCK
#define PROBE_UNIT_BLOCK 0
#endif
template <class Epi, class Sched, bool ALIGN_EPI = false, bool SP2 = false>
__device__ __forceinline__ void gemm_phase(PG8_LAS unsigned char* lds, const Gemm g, const Sched& S, const Epi& E, const int wid, unsigned* g_probe_unit = nullptr) {
    const int lane = lane_id_fresh(), tid = wid * 64 + lane, wr = wid >> 2, wc = wid & 3, fr = lane & 15, fq = lane >> 4;
    const int K = g.K, nt = K / BK;
    unsigned voffA[2], voffB[2];
#pragma unroll
    for (int i = 0; i < 2; ++i) { int R, C; stage_rc(tid * 16 + i * 8192, R, C); const int Rb = Epi::PERM ? ((R & ~31) + perm32(R & 31)) : R;
        voffA[i] = (unsigned)(R * K + C) * 2u; voffB[i] = (unsigned)(Rb * K + C) * 2u; }
    const size_t kstep = (size_t)(BK * 2);
    const size_t hstep = (size_t)HALF * K * 2;
    const size_t tstep = 2 * hstep;
    const unsigned ldsw = (unsigned)wid * 1024u;
    const int aoff = lds_byte(wr * 64 + fr, fq * 8), boff = lds_byte(wc * 32 + fr, fq * 8);
#define PG8_SA(b, h) (((b) * 2 + (h)) * HTB)
#define PG8_SB(b, h) ((4 + (b) * 2 + (h)) * HTB)
#if defined(PROBE_NODMA)
#define PG8_STAGE_COND (blockIdx.x != PROBE_UNIT_BLOCK)
#else
#define PG8_STAGE_COND true
#endif
#define PG8_STAGE(bufoff, gbase, voff) do { if (PG8_STAGE_COND) _Pragma("unroll") for (int _i = 0; _i < 2; ++_i) \
        __builtin_amdgcn_global_load_lds((const unsigned*)((const char*)(gbase) + (voff)[_i]), (PG8_LAS unsigned*)(lds + (bufoff) + ldsw + _i * 8192), 16, 0, 0); } while (0)
#define PG8_LDA(dst, b, h) do { _Pragma("unroll") for (int m = 0; m < 4; ++m) _Pragma("unroll") for (int k = 0; k < 2; ++k) dst[m][k] = *(const PG8_LAS bf16x8*)(lds + PG8_SA(b, h) + aoff + m * 2048 + k * 1024); } while (0)
#define PG8_LDB(dst, b, h) do { _Pragma("unroll") for (int n = 0; n < 2; ++n) _Pragma("unroll") for (int k = 0; k < 2; ++k) dst[n][k] = *(const PG8_LAS bf16x8*)(lds + PG8_SB(b, h) + boff + n * 2048 + k * 1024); } while (0)
#define PG8_MMA(ai, bj, At, Bt) do { __builtin_amdgcn_s_setprio(1); _Pragma("unroll") for (int m = 0; m < 4; ++m) _Pragma("unroll") for (int n = 0; n < 2; ++n) _Pragma("unroll") for (int k = 0; k < 2; ++k) \
        acc[ai][bj][m][n] = __builtin_amdgcn_mfma_f32_16x16x32_bf16(Bt[n][k], At[m][k], acc[ai][bj][m][n], 0, 0, 0); __builtin_amdgcn_s_setprio(0); } while (0)
#define PG8_LDB0(dst, b, h) do { _Pragma("unroll") for (int k = 0; k < 2; ++k) dst[0][k] = *(const PG8_LAS bf16x8*)(lds + PG8_SB(b, h) + boff + k * 1024); } while (0)
#define PG8_MMA0(ai, At, Bt) do { __builtin_amdgcn_s_setprio(1); _Pragma("unroll") for (int m = 0; m < 4; ++m) _Pragma("unroll") for (int k = 0; k < 2; ++k) \
        acc[ai][0][m][0] = __builtin_amdgcn_mfma_f32_16x16x32_bf16(Bt[0][k], At[m][k], acc[ai][0][m][0], 0, 0, 0); __builtin_amdgcn_s_setprio(0); } while (0)
#define PG8_MMAR(ai, At, Bt0, Bt1) do { __builtin_amdgcn_s_setprio(1); _Pragma("unroll") for (int m = 0; m < 4; ++m) _Pragma("unroll") for (int k = 0; k < 2; ++k) \
        acc[ai][0][m][1] = __builtin_amdgcn_mfma_f32_16x16x32_bf16(Bt0[1][k], At[m][k], acc[ai][0][m][1], 0, 0, 0); \
        _Pragma("unroll") for (int m = 0; m < 4; ++m) _Pragma("unroll") for (int n = 0; n < 2; ++n) _Pragma("unroll") for (int k = 0; k < 2; ++k) \
        acc[ai][1][m][n] = __builtin_amdgcn_mfma_f32_16x16x32_bf16(Bt1[n][k], At[m][k], acc[ai][1][m][n], 0, 0, 0); __builtin_amdgcn_s_setprio(0); } while (0)
#if defined(PROBE_NOMFMA)
#define PG8_MMA0_COND (!(narrow && blockIdx.x == PROBE_UNIT_BLOCK))
#else
#define PG8_MMA0_COND true
#endif
#define PG8_MMAS(ai, At, Bt0, Bt1) do { if constexpr (Epi::NARROW_PN >= 0) { if (PG8_MMA0_COND) PG8_MMA0(ai, At, Bt0); if (!narrow) PG8_MMAR(ai, At, Bt0, Bt1); } else { PG8_MMA(ai, 0, At, Bt0); PG8_MMA(ai, 1, At, Bt1); } } while (0)
#define PG8_WAIT_V(n) asm volatile("s_waitcnt vmcnt(" #n ")" ::: "memory")
#define PG8_WAIT_L(n) asm volatile("s_waitcnt lgkmcnt(" #n ")" ::: "memory")
#define PG8_BAR __builtin_amdgcn_s_barrier()
#define PG8_SCHED __builtin_amdgcn_sched_barrier(0)
    Unit cur, nxt; int ui = 0;
    if (!S.next(0, cur)) return;
    f32x4 acc[2][2][4][2];
#pragma unroll
    for (int a = 0; a < 2; ++a)
#pragma unroll
        for (int b = 0; b < 2; ++b)
#pragma unroll
            for (int m = 0; m < 4; ++m)
#pragma unroll
                for (int n = 0; n < 2; ++n) acc[a][b][m][n] = (f32x4){0.f, 0.f, 0.f, 0.f};
    bf16x8 At[4][2], B0[2][2], B1[2][2];
    const char* cA = (const char*)g.A + (size_t)cur.pm * tstep + (size_t)cur.k0 * 2; const char* cB = (const char*)g.Bt + (size_t)cur.pn * tstep + (size_t)cur.k0 * 2;
    S.a_ready(cur);
    if constexpr (SP2) {
        PG8_STAGE(PG8_SB(0, 0), cB, voffB); PG8_STAGE(PG8_SB(0, 1), cB + hstep, voffB); PG8_STAGE(PG8_SA(0, 0), cA, voffA); PG8_STAGE(PG8_SA(0, 1), cA + hstep, voffA);
        if (wr == 1) PG8_BAR;
        PG8_WAIT_V(2); PG8_BAR;
        PG8_STAGE(PG8_SB(1, 0), cB + kstep, voffB); PG8_STAGE(PG8_SA(1, 0), cA + kstep, voffA); PG8_STAGE(PG8_SB(1, 1), cB + hstep + kstep, voffB);
        PG8_WAIT_V(6); PG8_BAR;
    } else {
        PG8_STAGE(PG8_SB(0, 0), cB, voffB); PG8_STAGE(PG8_SA(0, 0), cA, voffA); PG8_STAGE(PG8_SB(0, 1), cB + hstep, voffB); PG8_STAGE(PG8_SA(0, 1), cA + hstep, voffA);
        if (wr == 1) PG8_BAR;
        PG8_WAIT_V(4); PG8_BAR;
        PG8_STAGE(PG8_SB(1, 0), cB + kstep, voffB); PG8_STAGE(PG8_SA(1, 0), cA + kstep, voffA); PG8_STAGE(PG8_SB(1, 1), cB + hstep + kstep, voffB);
        PG8_WAIT_V(6); PG8_BAR;
    }
    for (;;) {
        const bool has_next = S.next(ui + 1, nxt);
        const char* nA = has_next ? (const char*)g.A + (size_t)nxt.pm * tstep + (size_t)nxt.k0 * 2 : cA; const char* nB = has_next ? (const char*)g.Bt + (size_t)nxt.pn * tstep + (size_t)nxt.k0 * 2 : cB;
        const int cnt = cur.nt > 0 ? cur.nt : nt;
        const bool narrow = (Epi::NARROW_PN >= 0) && (cur.pn == Epi::NARROW_PN);
        for (int t = 0; t < cnt; t += 2) {
            const bool last = (t == cnt - 2);
            const char* a1 = cA + (size_t)(t + 1) * kstep;
            const char* a2 = last ? nA : cA + (size_t)(t + 2) * kstep; const char* b2 = last ? nB : cB + (size_t)(t + 2) * kstep;
            const char* a3 = a2 + kstep; const char* b3 = b2 + kstep;
            if (last && has_next) S.a_ready(nxt);
            if constexpr (SP2) {
            PG8_LDB(B0, 0, 0); PG8_LDB(B1, 0, 1); PG8_SCHED; PG8_LDA(At, 0, 0); PG8_STAGE(PG8_SA(1, 1), a1 + hstep, voffA);
            PG8_WAIT_V(8); PG8_WAIT_L(0); PG8_BAR; PG8_MMAS(0, At, B0, B1); PG8_BAR; PG8_SCHED;
            PG8_LDA(At, 0, 1); PG8_STAGE(PG8_SB(0, 0), b2, voffB); PG8_STAGE(PG8_SB(0, 1), b2 + hstep, voffB); PG8_STAGE(PG8_SA(0, 0), a2, voffA);
            PG8_WAIT_V(8); PG8_WAIT_L(0); PG8_BAR; PG8_MMAS(1, At, B0, B1); PG8_BAR; PG8_SCHED;
            PG8_LDB(B0, 1, 0); PG8_LDB(B1, 1, 1); PG8_SCHED; PG8_LDA(At, 1, 0); PG8_STAGE(PG8_SA(0, 1), a2 + hstep, voffA);
            PG8_WAIT_V(8); PG8_WAIT_L(0); PG8_BAR; PG8_MMAS(0, At, B0, B1); PG8_BAR; PG8_SCHED;
            PG8_LDA(At, 1, 1); PG8_STAGE(PG8_SB(1, 0), b3, voffB); PG8_STAGE(PG8_SB(1, 1), b3 + hstep, voffB); PG8_STAGE(PG8_SA(1, 0), a3, voffA);
            PG8_WAIT_V(8); PG8_WAIT_L(0); PG8_BAR; PG8_MMAS(1, At, B0, B1); PG8_BAR; PG8_SCHED;
            } else {
            PG8_LDB(B0, 0, 0); PG8_SCHED; PG8_LDA(At, 0, 0); PG8_STAGE(PG8_SA(1, 1), a1 + hstep, voffA);
            PG8_WAIT_L(8); PG8_BAR; PG8_WAIT_L(0); PG8_MMA(0, 0, At, B0); PG8_BAR; PG8_SCHED;
            PG8_LDB(B1, 0, 1); PG8_STAGE(PG8_SB(0, 0), b2, voffB);
            PG8_BAR; PG8_WAIT_L(0); PG8_MMA(0, 1, At, B1); PG8_BAR;
            PG8_LDA(At, 0, 1); PG8_STAGE(PG8_SA(0, 0), a2, voffA);
            PG8_BAR; PG8_WAIT_L(0); PG8_MMA(1, 0, At, B0); PG8_BAR; PG8_SCHED;
            PG8_STAGE(PG8_SB(0, 1), b2 + hstep, voffB);
            PG8_WAIT_V(6); PG8_BAR; PG8_MMA(1, 1, At, B1); PG8_BAR;
            PG8_LDB(B0, 1, 0); PG8_SCHED; PG8_LDA(At, 1, 0); PG8_STAGE(PG8_SA(0, 1), a2 + hstep, voffA);
            PG8_WAIT_L(8); PG8_BAR; PG8_WAIT_L(0); PG8_MMA(0, 0, At, B0); PG8_BAR; PG8_SCHED;
            PG8_LDB(B1, 1, 1); PG8_STAGE(PG8_SB(1, 0), b3, voffB);
            PG8_BAR; PG8_WAIT_L(0); PG8_MMA(0, 1, At, B1); PG8_BAR;
            PG8_LDA(At, 1, 1); PG8_STAGE(PG8_SA(1, 0), a3, voffA);
            PG8_BAR; PG8_WAIT_L(0); PG8_MMA(1, 0, At, B0); PG8_BAR; PG8_SCHED;
            PG8_STAGE(PG8_SB(1, 1), b3 + hstep, voffB);
            PG8_WAIT_V(6); PG8_BAR; PG8_MMA(1, 1, At, B1); PG8_BAR;
            }
        }
        if constexpr (ALIGN_EPI) { if (wr == 0) PG8_BAR; }
#if defined(PROBE_UNIT)
        if (blockIdx.x == PROBE_UNIT_BLOCK && wid == 0 && lane == 0 && g_probe_unit) { g_probe_unit[2 * ui] = (unsigned)__builtin_amdgcn_s_memrealtime(); }
#endif
        if constexpr (!Epi::AFTER_DRAIN) { E(acc, cur, wr, wc, fr, fq); S.done(cur); }
#if defined(PROBE_UNIT)
        if (blockIdx.x == PROBE_UNIT_BLOCK && wid == 0 && lane == 0 && g_probe_unit) { asm volatile("s_waitcnt vmcnt(0)" ::: "memory"); g_probe_unit[2 * ui + 1] = (unsigned)__builtin_amdgcn_s_memrealtime(); }
#endif
        if (!has_next) break;
#pragma unroll
        for (int a = 0; a < 2; ++a)
#pragma unroll
            for (int b = 0; b < 2; ++b)
#pragma unroll
                for (int m = 0; m < 4; ++m)
#pragma unroll
                    for (int n = 0; n < 2; ++n) acc[a][b][m][n] = (f32x4){0.f, 0.f, 0.f, 0.f};
        cur = nxt; cA = nA; cB = nB; ++ui;
        if constexpr (ALIGN_EPI) { if (wr == 1) PG8_BAR; }
    }
    PG8_WAIT_V(0);
    if constexpr (!ALIGN_EPI) { if (wr == 0) PG8_BAR; }
    PG8_BAR;
    if constexpr (Epi::AFTER_DRAIN) { E.fused(acc, cur, wr, wc, fr, fq, lds, wid, lane); S.done(cur); }
#undef PG8_SA
#undef PG8_SB
#undef PG8_STAGE
#undef PG8_LDA
#undef PG8_LDB
#undef PG8_MMA
#undef PG8_MMA0
#undef PG8_MMAR
#undef PG8_MMAS
#undef PG8_LDB0
#undef PG8_WAIT_V
#undef PG8_WAIT_L
#undef PG8_BAR
#undef PG8_SCHED
}
}
#define GAS __attribute__((address_space(1)))
#define LAS __attribute__((address_space(3)))
typedef unsigned short bf16;
typedef unsigned v4u __attribute__((ext_vector_type(4)));
typedef float f32x4 __attribute__((ext_vector_type(4)));
typedef short bf16x8 __attribute__((ext_vector_type(8)));
typedef GAS unsigned gu32;
typedef GAS unsigned long long gu64;
#define RLX_AGENT __ATOMIC_RELAXED, __HIP_MEMORY_SCOPE_AGENT
#define LDS_WAIT() asm volatile("s_waitcnt lgkmcnt(0)" ::: "memory")
#define VM_WAIT() asm volatile("s_waitcnt vmcnt(0)" ::: "memory")
__device__ __forceinline__ unsigned long long rt() { return __builtin_amdgcn_s_memrealtime(); }
__device__ __forceinline__ unsigned f2bf(float f) { unsigned u = __builtin_bit_cast(unsigned, f); return (u + 0x7fffu + ((u >> 16) & 1u)) >> 16; }
__device__ __forceinline__ unsigned pk2(float lo, float hi) { return f2bf(lo) | (f2bf(hi) << 16); }
#define XB_TMO      128
#define XB_XCNT(j)  (256  + 64 * (j))
#define XB_XSUB(j)  (1280 + 64 * (j))
#define XB_XGEN(j)  (2304 + 64 * (j))
#define XB_TOP      3328
#define XB_TOPGEN   3392
#define XCD_BAR_WORDS 3456
#define XB_SPIN_CAP (1u << 18)

__device__ __forceinline__ unsigned xb_ld(unsigned* p)              { return __hip_atomic_load(p, __ATOMIC_RELAXED, __HIP_MEMORY_SCOPE_AGENT); }
__device__ __forceinline__ unsigned xb_add(unsigned* p, unsigned v) { return __hip_atomic_fetch_add(p, v, __ATOMIC_RELAXED, __HIP_MEMORY_SCOPE_AGENT); }
__device__ __forceinline__ unsigned xb_xcc_id() { return (unsigned)__builtin_amdgcn_s_getreg((3 << 11) | 20) & 0xFu; }
#define XB_SPIN(cond, bar) do { unsigned _sp = 0; while (cond) { __builtin_amdgcn_s_sleep(1); \
    if ((++_sp & 255u) == 0u) { if (xb_ld(&(bar)[XB_TMO])) break; if (_sp > XB_SPIN_CAP) { atomicAdd(&(bar)[XB_TMO], 1u); break; } } } } while (0)

struct XcdBarrier {
    unsigned* bar; unsigned x;
    volatile LAS unsigned* st;
};

__device__ __forceinline__ XcdBarrier xcd_barrier_post(unsigned* bar, volatile LAS unsigned* st, bool leader) {
    XcdBarrier b; b.bar = bar; b.x = xb_xcc_id(); b.st = st;
    if (leader) (void)xb_add(&bar[XB_XCNT(b.x)], 1u);
    return b;
}
__device__ __forceinline__ void xcd_barrier_complete(unsigned* bar, unsigned x, unsigned& nloc, unsigned& nx) {
    const unsigned G = gridDim.x * gridDim.y * gridDim.z;
    unsigned sum, cnt, mine, sp = 0u;
    for (;;) {
        sum = 0u; cnt = 0u; mine = 0u;
#pragma unroll
        for (unsigned j = 0; j < 16; ++j) { const unsigned c = xb_ld(&bar[XB_XCNT(j)]); sum += c; cnt += (c > 0u) ? 1u : 0u; mine = (j == x) ? c : mine; }
        if (sum == G) break;
        __builtin_amdgcn_s_sleep(1);
        if ((++sp & 255u) == 0u) { if (xb_ld(&bar[XB_TMO])) break; if (sp > XB_SPIN_CAP) { atomicAdd(&bar[XB_TMO], 1u); break; } }
    }
    nloc = mine > 0u ? mine : 1u; nx = cnt > 0u ? cnt : 1u;
}

__device__ __forceinline__ void xcd_barrier(const XcdBarrier& b, bool leader) {
    asm volatile("s_waitcnt vmcnt(0)" ::: "memory");
    __syncthreads();
    if (leader) {
        unsigned* bar = b.bar;
        __builtin_amdgcn_s_waitcnt(0);
        unsigned nloc = b.st[0], nx = b.st[1];
        if (nloc == 0u) { xcd_barrier_complete(bar, b.x, nloc, nx); b.st[0] = nloc; b.st[1] = nx; }
        const unsigned old = xb_add(&bar[XB_XSUB(b.x)], 1u);
        const unsigned gen = old / nloc;
        if (old + 1u == (gen + 1u) * nloc) {
            __builtin_amdgcn_fence(__ATOMIC_RELEASE, "agent");
            asm volatile("s_waitcnt vmcnt(0)" ::: "memory");
            const unsigned og = xb_add(&bar[XB_TOP], 1u);
            const unsigned tg = og / nx;
            if (og + 1u == (tg + 1u) * nx) xb_add(&bar[XB_TOPGEN], 1u);
            else XB_SPIN(xb_ld(&bar[XB_TOPGEN]) == tg, bar);
            __builtin_amdgcn_fence(__ATOMIC_ACQUIRE, "agent");
            xb_add(&bar[XB_XGEN(b.x)], 1u);
            asm volatile("s_waitcnt vmcnt(0)" ::: "memory");
        } else {
            XB_SPIN(xb_ld(&bar[XB_XGEN(b.x)]) == gen, bar);
            __builtin_amdgcn_fence(__ATOMIC_ACQUIRE, "agent");
            asm volatile("s_waitcnt vmcnt(0)" ::: "memory");
        }
    }
    __syncthreads();
}
#ifndef MK_N_LAUNCHES
#define MK_N_LAUNCHES 1
#endif
constexpr int NWAVES = 8, NTHREADS = 512;
constexpr int DM = 2048, NB = 4, SEQ = 4096, NMETA = 16, LP = NMETA + SEQ, DB = 8, DS = 64, PAST = 1024, LS = PAST + DS;
constexpr int NH = 8, DIN = 3904, DINP = 4096, DFF = 5632, QLORA = 512, KVLORA = 256, ROPE = 64, ZC = 832;
constexpr int RP = NB * SEQ, RS = DB * DS, R = RP + RS, MP = R + 256;
constexpr int KPB = 64 + SEQ, KVP = NB * KPB, KVROWS = KVP + DB * LS;
constexpr float EPS = 1e-6f, LOG2E = 1.4426950408889634f;
constexpr float C2D = 0.125f * LOG2E, C2M = 0.07216878364870323f * LOG2E;
constexpr float LAM_INIT = 0.2f;
static_assert(R == 16896 && MP == 17152 && KVROWS == 25344 && LP == 4112, "shapes");
constexpr size_t O_Y = 0, O_KP = (size_t)R * DM, O_VP = O_KP + (size_t)NB * LP * 1024, O_CKVP = O_VP + (size_t)NB * LP * 1024, O_KRP = O_CKVP + (size_t)NB * LP * 256,
                 O_KS = O_KRP + (size_t)NB * LP * 64, O_VS = O_KS + (size_t)DB * DS * 1024, O_CKVS = O_VS + (size_t)DB * DS * 1024, O_KRS = O_CKVS + (size_t)DB * DS * 256, O_END = O_KRS + (size_t)DB * DS * 64;
static_assert(O_END == 74764288, "d_out size");
constexpr size_t DO_H1 = 0, DO_ZC = (size_t)MP * DM * 2, DO_ZC_END = DO_ZC + (size_t)MP * ZC * 4;
constexpr size_t DO_CQN = 0, DO_CKVN = (size_t)R * QLORA * 2, DO_CKVN_END = DO_CKVN + (size_t)KVROWS * KVLORA * 2;
constexpr size_t DO_OSCR = 0;
constexpr size_t DO_KR = (size_t)32 << 20, DO_KR_END = DO_KR + (size_t)KVROWS * ROPE * 2;
static_assert(DO_ZC_END <= (size_t)R * DM * 4 && DO_CKVN_END <= DO_ZC, "d_out scratch map");
static_assert(DO_CKVN_END <= DO_KR && DO_KR_END <= DO_ZC, "d_out scratch map (Kr)");
constexpr size_t MiB = 1u << 20;
constexpr size_t WS_CTL = 0, CTL_ZERO_BYTES = 1 * MiB;
constexpr size_t WS_WIN = 1 * MiB, WS_WUQ = 17 * MiB, WS_WUKV = WS_WUQ + 3 * MiB / 2, WS_WOUT = WS_WUKV + 1 * MiB, WS_WGU = WS_WOUT + 8 * MiB, WS_WD = WS_WGU + 44 * MiB, WS_WEND = WS_WD + 22 * MiB;
constexpr size_t WS_QD = 94 * MiB, WS_KD = WS_QD + 33 * MiB, WS_VD = WS_KD + (size_t)KVROWS * 2048, WS_VM = WS_VD + (size_t)KVROWS * 2048, WS_KM = WS_VM + (size_t)KVROWS * 2048,
                 WS_QM = WS_KM + (size_t)KVROWS * 3072, WS_MIX = WS_QM + (size_t)R * 3072, WS_MIX_END = WS_MIX + (size_t)R * 4096;
constexpr size_t WS_X2B = WS_QD, WS_H = WS_VM, WS_SLAB = WS_VD;
constexpr size_t WS_PART2 = 466 * MiB, WS_PART3 = 469 * MiB, WS_ROPE = 472 * MiB, WS_END = 474 * MiB;
static_assert(WS_SLAB + (size_t)176 * 262144 <= WS_VM && WS_WEND <= WS_QD && WS_MIX_END <= WS_PART2 && WS_X2B + (size_t)R * 4096 <= WS_VM && WS_H + (size_t)R * DFF * 2 <= WS_PART2 && WS_PART2 + (size_t)R * 128 <= WS_PART3 && WS_PART3 + (size_t)R * 128 + (size_t)R * 4 <= WS_ROPE && WS_ROPE + (size_t)LP * 256 <= WS_END, "d_ws map");
constexpr int CW_QUEUE = 64;
constexpr int CW_BAR = 4096;
constexpr int CTL_ZERO_WORDS = 8192;
constexpr int RING_BYTES = 131072, LDS_BYTES = 163840, LDSCTL_OFF = LDS_BYTES - 512, MISC_OFF = LDSCTL_OFF + 320;

typedef float f32x2 __attribute__((ext_vector_type(2)));
typedef unsigned u32x2 __attribute__((ext_vector_type(2)));
__device__ __forceinline__ float wave_sum(float v) {
#pragma unroll
    for (int o = 1; o < 64; o <<= 1) v += __shfl_xor(v, o);
    return v;
}
__device__ __forceinline__ float rsqrt_f(float x) { return 1.0f / sqrtf(x); }

namespace epi {
using pg8::Unit; using pg8::bf16_t; using pg8::cvt_pk_bf16; using pg8::HALF; using pg8::BM; using pg8::u32x4;

struct EpiIn {
    static constexpr bool PERM = true, AFTER_DRAIN = false; static constexpr int NARROW_PN = 15;
    bf16_t *Qd, *Kd, *Vd; float* zc; float* out;
    __device__ __forceinline__ void st_kv(const f32x4& v0, const f32x4& v1, float* of, bf16_t* ob) const {
        *(f32x4*)of = v0; *(f32x4*)(of + 4) = v1;
        u32x4 w; w.x = cvt_pk_bf16(v0[0], v0[1]); w.y = cvt_pk_bf16(v0[2], v0[3]); w.z = cvt_pk_bf16(v1[0], v1[1]); w.w = cvt_pk_bf16(v1[2], v1[3]);
        *(u32x4*)ob = w;
    }
    __device__ __forceinline__ void operator()(const f32x4 (&acc)[2][2][4][2], const Unit& u, int wr, int wc, int fr_, int fq_) const {
        int fr = fr_, fq = fq_; asm volatile("" : "+v"(fr), "+v"(fq));
        const int pm = u.pm, cat = u.pn >> 2, colt = (u.pn & 3) * 256 + wc * 32 + 8 * fq;
        bf16_t* zb = (bf16_t*)zc;
        if (u.pn == NARROW_PN) {
            const int col = 768 + 16 * wc + 4 * fq;
            if (pm == 66) { if (wr == 0) { const f32x4 v = acc[0][0][0][0]; *(u32x2*)(zb + (size_t)(R + fr) * ZC + col) = (u32x2){cvt_pk_bf16(v[0], v[1]), cvt_pk_bf16(v[2], v[3])}; } return; }
#pragma unroll
            for (int ai = 0; ai < 2; ++ai)
#pragma unroll
                for (int m = 0; m < 4; ++m) { const size_t r = (size_t)pm * BM + ai * HALF + wr * 64 + m * 16 + fr; const f32x4 v = acc[ai][0][m][0]; *(u32x2*)(zb + r * ZC + col) = (u32x2){cvt_pk_bf16(v[0], v[1]), cvt_pk_bf16(v[2], v[3])}; }
            return;
        }
        if (pm == 66) {
            if (wr != 0 || cat == 0) return;
#pragma unroll
            for (int bj = 0; bj < 2; ++bj) { const int col = colt + bj * HALF; const f32x4 v0 = acc[0][bj][0][0], v1 = acc[0][bj][0][1];
                if (cat == 3) { if (col < ZC) { u32x4 w; w.x = cvt_pk_bf16(v0[0], v0[1]); w.y = cvt_pk_bf16(v0[2], v0[3]); w.z = cvt_pk_bf16(v1[0], v1[1]); w.w = cvt_pk_bf16(v1[2], v1[3]); *(u32x4*)(zb + (size_t)(R + fr) * ZC + col) = w; } }
                else { for (int b = 0; b < NB; ++b) { const size_t orow = (size_t)b * LP + fr, krow = (size_t)b * KPB + fr;
                        st_kv(v0, v1, out + (cat == 1 ? O_KP : O_VP) + orow * 1024 + col, (cat == 1 ? Kd : Vd) + krow * 1024 + col); } } }
            return;
        }
#pragma unroll
        for (int ai = 0; ai < 2; ++ai)
#pragma unroll
            for (int m = 0; m < 4; ++m) {
                const int rit = ai * HALF + wr * 64 + m * 16 + fr; const size_t r = (size_t)pm * BM + rit;
                size_t orow, krow; size_t obase_k, obase_v;
                if (pm < 64) { const int b = pm >> 4, t = (pm & 15) * 256 + rit; orow = (size_t)b * LP + NMETA + t; krow = (size_t)b * KPB + 64 + t; obase_k = O_KP; obase_v = O_VP; }
                else { const int rr = (pm - 64) * 256 + rit, b = rr >> 6, j = rr & 63; orow = (size_t)b * DS + j; krow = (size_t)KVP + (size_t)b * LS + PAST + j; obase_k = O_KS; obase_v = O_VS; }
#pragma unroll
                for (int bj = 0; bj < 2; ++bj) { const int col = colt + bj * HALF; const f32x4 v0 = acc[ai][bj][m][0], v1 = acc[ai][bj][m][1];
                    if (cat == 0) { u32x4 w; w.x = cvt_pk_bf16(v0[0] * C2D, v0[1] * C2D); w.y = cvt_pk_bf16(v0[2] * C2D, v0[3] * C2D); w.z = cvt_pk_bf16(v1[0] * C2D, v1[1] * C2D); w.w = cvt_pk_bf16(v1[2] * C2D, v1[3] * C2D);
                        *(u32x4*)(Qd + r * 1024 + col) = w; }
                    else if (cat == 1) st_kv(v0, v1, out + obase_k + orow * 1024 + col, Kd + krow * 1024 + col);
                    else if (cat == 2) st_kv(v0, v1, out + obase_v + orow * 1024 + col, Vd + krow * 1024 + col);
                    else if (col < ZC) { u32x4 w; w.x = cvt_pk_bf16(v0[0], v0[1]); w.y = cvt_pk_bf16(v0[2], v0[3]); w.z = cvt_pk_bf16(v1[0], v1[1]); w.w = cvt_pk_bf16(v1[2], v1[3]); *(u32x4*)(zb + r * ZC + col) = w; } }
            }
    }
};

struct EpiUq {
    static constexpr bool PERM = true, AFTER_DRAIN = false; static constexpr int NARROW_PN = -1;
    bf16_t* Qm; const f32x2* rope;
    __device__ __forceinline__ void operator()(const f32x4 (&acc)[2][2][4][2], const Unit& u, int wr, int wc, int fr_, int fq_) const {
        int fr = fr_, fq = fq_; asm volatile("" : "+v"(fr), "+v"(fq));
#pragma unroll
        for (int bj = 0; bj < 2; ++bj) { const int n8 = u.pn * BM + bj * HALF + wc * 32 + 8 * fq, h = n8 / 192, j8 = n8 - h * 192;
            f32x4 csA[2][4], csB[2][4];
            if (j8 >= 128) { const int i0p = (j8 - 128) >> 1;
#pragma unroll
                for (int ai = 0; ai < 2; ++ai)
#pragma unroll
                    for (int m = 0; m < 4; ++m) { const size_t r = (size_t)u.pm * BM + ai * HALF + wr * 64 + m * 16 + fr; const int pos = (u.pm < 64) ? NMETA + (int)(r & 4095) : PAST + (int)((r - RP) & 63);
                        csA[ai][m] = *(const f32x4*)(rope + (size_t)pos * 32 + i0p); csB[ai][m] = *(const f32x4*)(rope + (size_t)pos * 32 + i0p + 2); } }
#pragma unroll
            for (int ai = 0; ai < 2; ++ai)
#pragma unroll
                for (int m = 0; m < 4; ++m) {
                    const int rit = ai * HALF + wr * 64 + m * 16 + fr; const size_t r = (size_t)u.pm * BM + rit;
                    const f32x4 v0 = acc[ai][bj][m][0] * C2M, v1 = acc[ai][bj][m][1] * C2M; bf16_t* qrow = Qm + r * 1536 + h * 192;
                    if (j8 < 128) { u32x4 w; w.x = cvt_pk_bf16(v0[0], v0[1]); w.y = cvt_pk_bf16(v0[2], v0[3]); w.z = cvt_pk_bf16(v1[0], v1[1]); w.w = cvt_pk_bf16(v1[2], v1[3]); *(u32x4*)(qrow + j8) = w; }
                    else { const int i0 = (j8 - 128) >> 1;
                        const f32x4 cs0 = csA[ai][m], cs1 = csB[ai][m];
                        const float a0 = v0[0] * cs0[0] - v0[1] * cs0[1], b0 = v0[0] * cs0[1] + v0[1] * cs0[0];
                        const float a1 = v0[2] * cs0[2] - v0[3] * cs0[3], b1 = v0[2] * cs0[3] + v0[3] * cs0[2];
                        const float a2 = v1[0] * cs1[0] - v1[1] * cs1[1], b2 = v1[0] * cs1[1] + v1[1] * cs1[0];
                        const float a3 = v1[2] * cs1[2] - v1[3] * cs1[3], b3 = v1[2] * cs1[3] + v1[3] * cs1[2];
                        u32x2 wa, wb; wa.x = cvt_pk_bf16(a0, a1); wa.y = cvt_pk_bf16(a2, a3); wb.x = cvt_pk_bf16(b0, b1); wb.y = cvt_pk_bf16(b2, b3);
                        *(u32x2*)(qrow + 128 + i0) = wa; *(u32x2*)(qrow + 160 + i0) = wb; }
                } }
    }
};

struct EpiUkv {
    static constexpr bool PERM = true, AFTER_DRAIN = false; static constexpr int NARROW_PN = -1;
    bf16_t *Km, *Vm;
    __device__ __forceinline__ void operator()(const f32x4 (&acc)[2][2][4][2], const Unit& u, int wr, int wc, int fr_, int fq_) const {
        int fr = fr_, fq = fq_; asm volatile("" : "+v"(fr), "+v"(fq));
        const int c8 = wc * 32 + 8 * fq;
#pragma unroll
        for (int ai = 0; ai < 2; ++ai)
#pragma unroll
            for (int m = 0; m < 4; ++m) { const size_t r = (size_t)u.pm * BM + ai * HALF + wr * 64 + m * 16 + fr;
#pragma unroll
                for (int bj = 0; bj < 2; ++bj) { const f32x4 v0 = acc[ai][bj][m][0], v1 = acc[ai][bj][m][1];
                    u32x4 w; w.x = cvt_pk_bf16(v0[0], v0[1]); w.y = cvt_pk_bf16(v0[2], v0[3]); w.z = cvt_pk_bf16(v1[0], v1[1]); w.w = cvt_pk_bf16(v1[2], v1[3]);
                    if (bj == 0) *(u32x4*)(Km + r * 1536 + u.pn * 192 + c8) = w; else *(u32x4*)(Vm + r * 1024 + u.pn * 128 + c8) = w; } }
    }
};

struct SplitOrder {
    pg8::StaticOrder full; int nN, nsplit, ksub, G, c;
    __device__ void init(int N, int K, int nsplit_, int G_, int c_) { full.init(RP, N, G_, c_,   4); nN = N / BM; nsplit = nsplit_; ksub = K / nsplit_; G = G_; c = c_; }
    __device__ __forceinline__ bool next(int i, Unit& u) const {
        const long L = (long)i * G + c; const int nfull = (RP / BM) * nN;
        Unit f; f.pm = 0; f.pn = 0; f.k0 = 0; f.nt = 0; f.ks = -1; bool ok = full.next(i, f);
        const int idx = (int)(L - nfull), ks_ = idx % nsplit, t = idx / nsplit;
        if (L >= nfull) { ok = idx < 2 * nN * nsplit; f.pm = RP / BM + t / nN; f.pn = t % nN; f.k0 = ks_ * ksub; f.nt = ksub / pg8::BK; f.ks = ks_; }
        u.pm = f.pm; u.pn = f.pn; u.k0 = f.k0; u.nt = f.nt; u.ks = f.ks; return ok;
    }
    __device__ __forceinline__ void a_ready(const Unit&) const {}
    __device__ __forceinline__ void done(const Unit&) const {}
};
constexpr int NSPLIT_OUT = 8, NSPLIT_DOWN = 11;
__device__ __forceinline__ void store_slab(const f32x4 (&acc)[2][2][4][2], const Unit& u, int nsplit, float* slab, int wr, int wc, int fr, int fq) {
    bf16_t* s = (bf16_t*)slab + (size_t)(((u.pm - RP / BM) * 8 + u.pn) * nsplit + u.ks) * 65536 + wc * 32 + 8 * fq;
#pragma unroll
    for (int ai = 0; ai < 2; ++ai)
#pragma unroll
        for (int m = 0; m < 4; ++m) { bf16_t* sr = s + (size_t)(ai * HALF + wr * 64 + m * 16 + fr) * 256;
#pragma unroll
            for (int bj = 0; bj < 2; ++bj) { const f32x4 v0 = acc[ai][bj][m][0], v1 = acc[ai][bj][m][1];
                u32x4 w; w.x = cvt_pk_bf16(v0[0], v0[1]); w.y = cvt_pk_bf16(v0[2], v0[3]); w.z = cvt_pk_bf16(v1[0], v1[1]); w.w = cvt_pk_bf16(v1[2], v1[3]); *(u32x4*)(sr + bj * HALF) = w; } }
}
struct EpiOut {
    static constexpr bool PERM = true, AFTER_DRAIN = false; static constexpr int NARROW_PN = -1;
    const float* xp; bf16_t* xb; float* part; float* slab;
    __device__ __forceinline__ void operator()(const f32x4 (&acc)[2][2][4][2], const Unit& u, int wr, int wc, int fr_, int fq_) const {
        int fr = fr_, fq = fq_; asm volatile("" : "+v"(fr), "+v"(fq));
        if (u.ks >= 0) { store_slab(acc, u, NSPLIT_OUT, slab, wr, wc, fr, fq); return; }
        const int col0 = u.pn * BM + wc * 32 + 8 * fq;
#pragma unroll
        for (int ai = 0; ai < 2; ++ai) {
            f32x4 xr[4][2][2];
#pragma unroll
            for (int m = 0; m < 4; ++m) { const float* xin = xp + ((size_t)u.pm * BM + ai * HALF + wr * 64 + m * 16 + fr) * DM + col0;
#pragma unroll
                for (int bj = 0; bj < 2; ++bj) { xr[m][bj][0] = __builtin_nontemporal_load((const f32x4*)(xin + bj * HALF)); xr[m][bj][1] = __builtin_nontemporal_load((const f32x4*)(xin + bj * HALF + 4)); } }
#pragma unroll
            for (int m = 0; m < 4; ++m) { const size_t r = (size_t)u.pm * BM + ai * HALF + wr * 64 + m * 16 + fr; float ss = 0.f;
#pragma unroll
                for (int bj = 0; bj < 2; ++bj) { const f32x4 v0 = xr[m][bj][0] + acc[ai][bj][m][0], v1 = xr[m][bj][1] + acc[ai][bj][m][1];
                    ss += ((v0[0] * v0[0] + v0[1] * v0[1]) + (v0[2] * v0[2] + v0[3] * v0[3])) + ((v1[0] * v1[0] + v1[1] * v1[1]) + (v1[2] * v1[2] + v1[3] * v1[3]));
                    u32x4 w; w.x = cvt_pk_bf16(v0[0], v0[1]); w.y = cvt_pk_bf16(v0[2], v0[3]); w.z = cvt_pk_bf16(v1[0], v1[1]); w.w = cvt_pk_bf16(v1[2], v1[3]);
                    *(u32x4*)(xb + r * DM + col0 + bj * HALF) = w; }
                ss += __shfl_xor(ss, 16); ss += __shfl_xor(ss, 32);
                if (fq == 0) part[r * 32 + u.pn * 4 + wc] = ss; }
        }
    }
};
struct EpiDown {
    static constexpr bool PERM = true, AFTER_DRAIN = false; static constexpr int NARROW_PN = -1;
    bf16_t* xb; float* part; float* slab;
    __device__ __forceinline__ void operator()(const f32x4 (&acc)[2][2][4][2], const Unit& u, int wr, int wc, int fr_, int fq_) const {
        int fr = fr_, fq = fq_; asm volatile("" : "+v"(fr), "+v"(fq));
        if (u.ks >= 0) { store_slab(acc, u, NSPLIT_DOWN, slab, wr, wc, fr, fq); return; }
        const int col0 = u.pn * BM + wc * 32 + 8 * fq;
        u32x4 xw[2][4][2];
#pragma unroll
        for (int ai = 0; ai < 2; ++ai)
#pragma unroll
            for (int m = 0; m < 4; ++m) { const bf16_t* xin = xb + ((size_t)u.pm * BM + ai * HALF + wr * 64 + m * 16 + fr) * DM + col0;
#pragma unroll
                for (int bj = 0; bj < 2; ++bj) xw[ai][m][bj] = *(const u32x4*)(xin + bj * HALF); }
#pragma unroll
        for (int ai = 0; ai < 2; ++ai)
#pragma unroll
            for (int m = 0; m < 4; ++m) { const size_t r = (size_t)u.pm * BM + ai * HALF + wr * 64 + m * 16 + fr; float ss = 0.f;
#pragma unroll
                for (int bj = 0; bj < 2; ++bj) { const u32x4 w = xw[ai][m][bj]; f32x4 v0 = acc[ai][bj][m][0], v1 = acc[ai][bj][m][1];
                    v0[0] += __uint_as_float(w.x << 16); v0[1] += __uint_as_float(w.x & 0xffff0000u); v0[2] += __uint_as_float(w.y << 16); v0[3] += __uint_as_float(w.y & 0xffff0000u);
                    v1[0] += __uint_as_float(w.z << 16); v1[1] += __uint_as_float(w.z & 0xffff0000u); v1[2] += __uint_as_float(w.w << 16); v1[3] += __uint_as_float(w.w & 0xffff0000u);
                    ss += ((v0[0] * v0[0] + v0[1] * v0[1]) + (v0[2] * v0[2] + v0[3] * v0[3])) + ((v1[0] * v1[0] + v1[1] * v1[1]) + (v1[2] * v1[2] + v1[3] * v1[3]));
                    u32x4 wo; wo.x = cvt_pk_bf16(v0[0], v0[1]); wo.y = cvt_pk_bf16(v0[2], v0[3]); wo.z = cvt_pk_bf16(v1[0], v1[1]); wo.w = cvt_pk_bf16(v1[2], v1[3]);
                    *(u32x4*)(xb + r * DM + col0 + bj * HALF) = wo; }
                ss += __shfl_xor(ss, 16); ss += __shfl_xor(ss, 32);
                if (fq == 0) part[r * 32 + u.pn * 4 + wc] = ss; }
    }
};

struct EpiGU {
    static constexpr bool PERM = true, AFTER_DRAIN = false; static constexpr int NARROW_PN = -1;
    bf16_t* H; const float* part;
    __device__ __forceinline__ static float silu_mul(float g, float uu) { return g * uu * __builtin_amdgcn_rcpf(1.0f + __builtin_amdgcn_exp2f(-g * LOG2E)); }
    __device__ __forceinline__ void operator()(const f32x4 (&acc)[2][2][4][2], const Unit& u, int wr, int wc, int fr_, int fq_) const {
        int fr = fr_, fq = fq_; asm volatile("" : "+v"(fr), "+v"(fq));
        const int col = u.pn * HALF + wc * 32 + 8 * fq;
        float rs8[2][4];
#pragma unroll
        for (int ai = 0; ai < 2; ++ai)
#pragma unroll
            for (int m = 0; m < 4; ++m) rs8[ai][m] = part[(size_t)u.pm * BM + ai * HALF + wr * 64 + m * 16 + fr];
#pragma unroll
        for (int ai = 0; ai < 2; ++ai)
#pragma unroll
            for (int m = 0; m < 4; ++m) { const size_t r = (size_t)u.pm * BM + ai * HALF + wr * 64 + m * 16 + fr;
                const float rstd = rs8[ai][m];
                const f32x4 g0 = acc[ai][0][m][0] * rstd, g1 = acc[ai][0][m][1] * rstd, u0 = acc[ai][1][m][0] * rstd, u1 = acc[ai][1][m][1] * rstd;
                u32x4 w; w.x = cvt_pk_bf16(silu_mul(g0[0], u0[0]), silu_mul(g0[1], u0[1])); w.y = cvt_pk_bf16(silu_mul(g0[2], u0[2]), silu_mul(g0[3], u0[3]));
                w.z = cvt_pk_bf16(silu_mul(g1[0], u1[0]), silu_mul(g1[1], u1[1])); w.w = cvt_pk_bf16(silu_mul(g1[2], u1[2]), silu_mul(g1[3], u1[3]));
                *(u32x4*)(H + r * DFF + col) = w; }
    }
};
}
constexpr int IN_TBL_N = 5, IN_TBL_CONV = 213;
__device__ const unsigned short in_tbl[256][6] = {
  {0,32,68,100,65535,0},
  {134,166,202,234,65535,1},
  {268,300,336,368,65535,2},
  {402,434,470,502,65535,3},
  {536,568,604,636,664,65535},
  {670,706,738,774,65535,4},
  {804,840,872,908,65535,5},
  {938,974,1006,1042,65535,6},
  {1,33,69,101,65535,7},
  {135,167,203,235,65535,8},
  {269,301,337,369,65535,9},
  {403,435,471,503,65535,10},
  {537,569,605,637,665,65535},
  {671,707,739,775,65535,11},
  {805,841,873,909,65535,12},
  {939,975,1007,1043,65535,13},
  {2,34,70,102,65535,14},
  {136,168,204,236,65535,15},
  {270,302,338,370,65535,16},
  {404,436,472,504,65535,17},
  {538,570,606,638,666,65535},
  {672,708,740,776,65535,18},
  {806,842,874,910,65535,19},
  {940,976,1008,1044,65535,20},
  {3,35,71,103,65535,21},
  {137,169,205,237,65535,22},
  {271,303,339,371,65535,23},
  {405,437,473,505,65535,24},
  {539,571,607,639,667,65535},
  {673,709,741,777,65535,25},
  {807,843,875,911,65535,26},
  {941,977,1009,1045,65535,27},
  {4,36,72,104,65535,28},
  {138,170,206,238,65535,29},
  {272,304,340,372,65535,30},
  {406,438,474,506,65535,31},
  {540,572,600,632,668,65535},
  {674,710,742,778,65535,32},
  {808,844,876,912,65535,33},
  {942,978,1010,1046,65535,34},
  {5,37,73,105,65535,35},
  {139,171,207,239,65535,36},
  {273,305,341,373,65535,37},
  {407,439,475,507,65535,38},
  {541,573,601,633,669,65535},
  {675,711,743,779,65535,39},
  {809,845,877,913,65535,40},
  {943,979,1011,1047,65535,41},
  {6,38,74,106,65535,42},
  {140,172,208,240,65535,43},
  {274,306,342,374,65535,44},
  {408,440,476,508,530,65535},
  {542,574,602,634,65535,45},
  {676,712,744,780,65535,46},
  {810,846,878,914,65535,47},
  {944,980,1012,1048,65535,48},
  {7,39,75,107,65535,49},
  {141,173,209,241,65535,50},
  {275,307,343,375,65535,51},
  {409,441,477,509,531,65535},
  {543,575,603,635,65535,52},
  {677,713,745,781,65535,53},
  {811,847,879,915,65535,54},
  {945,981,1013,1049,65535,55},
  {8,40,76,108,65535,56},
  {142,174,210,242,65535,57},
  {276,308,344,376,65535,58},
  {410,442,478,510,532,65535},
  {544,576,608,640,65535,59},
  {678,714,746,782,65535,60},
  {812,848,880,916,65535,61},
  {946,982,1014,1050,65535,62},
  {9,41,77,109,65535,63},
  {143,175,211,243,65535,64},
  {277,309,345,377,65535,65},
  {411,443,479,511,533,65535},
  {545,577,609,641,65535,66},
  {679,715,747,783,65535,67},
  {813,849,881,917,65535,68},
  {947,983,1015,1051,65535,69},
  {10,42,78,110,65535,70},
  {144,176,212,244,65535,71},
  {278,310,346,378,65535,72},
  {412,444,466,498,534,65535},
  {546,578,610,642,65535,73},
  {680,716,748,784,65535,74},
  {814,850,882,918,65535,75},
  {948,984,1016,1052,65535,76},
  {11,43,79,111,65535,77},
  {145,177,213,245,65535,78},
  {279,311,347,379,65535,79},
  {413,445,467,499,535,65535},
  {547,579,611,643,65535,80},
  {681,717,749,785,65535,81},
  {815,851,883,919,65535,82},
  {949,985,1017,1053,65535,83},
  {12,44,80,112,65535,84},
  {146,178,214,246,65535,85},
  {280,312,348,380,396,65535},
  {414,446,468,500,65535,86},
  {548,580,612,644,65535,87},
  {682,718,750,786,65535,88},
  {816,852,884,920,65535,89},
  {950,986,1018,1054,65535,90},
  {13,45,81,113,65535,91},
  {147,179,215,247,65535,92},
  {281,313,349,381,397,65535},
  {415,447,469,501,65535,93},
  {549,581,613,645,65535,94},
  {683,719,751,787,65535,95},
  {817,853,885,921,65535,96},
  {951,987,1019,1055,65535,97},
  {14,46,82,114,65535,98},
  {148,180,216,248,65535,99},
  {282,314,350,382,398,65535},
  {416,448,480,512,65535,100},
  {550,582,614,646,65535,101},
  {684,720,752,788,65535,102},
  {818,854,886,922,65535,103},
  {952,988,1020,1034,1066,65535},
  {15,47,83,115,65535,104},
  {149,181,217,249,65535,105},
  {283,315,351,383,399,65535},
  {417,449,481,513,65535,106},
  {551,583,615,647,65535,107},
  {685,721,753,789,65535,108},
  {819,855,887,923,65535,109},
  {953,989,1021,1035,1067,65535},
  {16,48,84,116,65535,110},
  {150,182,218,250,65535,111},
  {284,316,332,364,400,65535},
  {418,450,482,514,65535,112},
  {552,584,616,648,65535,113},
  {686,722,754,790,65535,114},
  {820,856,888,924,65535,115},
  {954,990,1022,1036,1068,65535},
  {17,49,85,117,65535,116},
  {151,183,219,251,65535,117},
  {285,317,333,365,401,65535},
  {419,451,483,515,65535,118},
  {553,585,617,649,65535,119},
  {687,723,755,791,65535,120},
  {821,857,889,925,65535,121},
  {955,991,1023,1037,1069,122},
  {18,50,86,118,65535,123},
  {152,184,220,252,262,65535},
  {286,318,334,366,65535,124},
  {420,452,484,516,65535,125},
  {554,586,618,650,65535,126},
  {688,724,756,792,65535,127},
  {822,858,890,926,65535,128},
  {956,970,1002,1038,1070,129},
  {19,51,87,119,65535,130},
  {153,185,221,253,263,65535},
  {287,319,335,367,65535,131},
  {421,453,485,517,65535,132},
  {555,587,619,651,65535,133},
  {689,725,757,793,65535,134},
  {823,859,891,927,65535,135},
  {957,971,1003,1039,1071,136},
  {20,52,88,120,65535,137},
  {154,186,222,254,264,65535},
  {288,320,352,384,65535,138},
  {422,454,486,518,65535,139},
  {556,588,620,652,65535,140},
  {690,726,758,794,65535,141},
  {824,860,892,900,932,65535},
  {958,972,1004,1040,65535,142},
  {21,53,89,121,65535,143},
  {155,187,223,255,265,65535},
  {289,321,353,385,65535,144},
  {423,455,487,519,65535,145},
  {557,589,621,653,65535,146},
  {691,727,759,795,65535,147},
  {825,861,893,901,933,65535},
  {959,973,1005,1041,65535,148},
  {22,54,90,122,65535,149},
  {156,188,198,230,266,65535},
  {290,322,354,386,65535,150},
  {424,456,488,520,65535,151},
  {558,590,622,654,65535,152},
  {692,728,760,796,65535,153},
  {826,862,894,902,934,65535},
  {960,992,1024,1056,65535,154},
  {23,55,91,123,65535,155},
  {157,189,199,231,267,65535},
  {291,323,355,387,65535,156},
  {425,457,489,521,65535,157},
  {559,591,623,655,65535,158},
  {693,729,761,797,65535,159},
  {827,863,895,903,935,65535},
  {961,993,1025,1057,65535,160},
  {24,56,92,124,128,65535},
  {158,190,200,232,65535,161},
  {292,324,356,388,65535,162},
  {426,458,490,522,65535,163},
  {560,592,624,656,65535,164},
  {694,730,762,798,65535,165},
  {828,836,868,904,936,65535},
  {962,994,1026,1058,65535,166},
  {25,57,93,125,129,65535},
  {159,191,201,233,65535,167},
  {293,325,357,389,65535,168},
  {427,459,491,523,65535,169},
  {561,593,625,657,65535,170},
  {695,731,763,799,65535,171},
  {829,837,869,905,937,65535},
  {963,995,1027,1059,65535,172},
  {26,58,94,126,130,65535},
  {160,192,224,256,65535,173},
  {294,326,358,390,65535,174},
  {428,460,492,524,65535,175},
  {562,594,626,658,65535,176},
  {696,732,764,768,800,65535},
  {830,838,870,906,65535,177},
  {964,996,1028,1060,65535,178},
  {27,59,95,127,131,65535},
  {161,193,225,257,65535,179},
  {295,327,359,391,65535,180},
  {429,461,493,525,65535,181},
  {563,595,627,659,65535,182},
  {697,733,765,769,801,65535},
  {831,839,871,907,65535,183},
  {965,997,1029,1061,65535,184},
  {28,60,64,96,132,65535},
  {162,194,226,258,65535,185},
  {296,328,360,392,65535,186},
  {430,462,494,526,65535,187},
  {564,596,628,660,65535,188},
  {698,734,766,770,802,65535},
  {832,864,896,928,65535,189},
  {966,998,1030,1062,65535,190},
  {29,61,65,97,133,65535},
  {163,195,227,259,65535,191},
  {297,329,361,393,65535,192},
  {431,463,495,527,65535,193},
  {565,597,629,661,65535,194},
  {699,735,767,771,803,65535},
  {833,865,897,929,65535,195},
  {967,999,1031,1063,65535,196},
  {30,62,66,98,65535,197},
  {164,196,228,260,65535,198},
  {298,330,362,394,65535,199},
  {432,464,496,528,65535,200},
  {566,598,630,662,65535,201},
  {700,702,704,736,772,202},
  {834,866,898,930,65535,203},
  {968,1000,1032,1064,65535,204},
  {31,63,67,99,65535,205},
  {165,197,229,261,65535,206},
  {299,331,363,395,65535,207},
  {433,465,497,529,65535,208},
  {567,599,631,663,65535,209},
  {701,703,705,737,773,210},
  {835,867,899,931,65535,211},
  {969,1001,1033,1065,65535,212},
};
template <class F> __device__ __forceinline__ void tr_item(const F& f, int K, bf16* WT, int k0, int n0, LAS float* scr, int lane) {
    float v_[32];
#pragma unroll
    for (int i = 0; i < 32; ++i) v_[i] = f(k0 + 2 * i + (lane >> 5), n0 + (lane & 31));
#pragma unroll
    for (int i = 0; i < 32; ++i) scr[(2 * i + (lane >> 5)) * 33 + (lane & 31)] = v_[i];
    LDS_WAIT(); asm volatile("" ::: "memory");
    const int c = lane & 7;
#pragma unroll
    for (int j = 0; j < 4; ++j) { const int n = (lane >> 3) + 8 * j; const LAS float* s = scr + (8 * c) * 33 + n;
        v4u o; o.x = pk2(s[0 * 33], s[1 * 33]); o.y = pk2(s[2 * 33], s[3 * 33]); o.z = pk2(s[4 * 33], s[5 * 33]); o.w = pk2(s[6 * 33], s[7 * 33]);
        *(GAS v4u*)(WT + (size_t)(n0 + n) * K + k0 + 8 * c) = o; }
    LDS_WAIT(); asm volatile("" ::: "memory");
}
struct SrcIn { const float* W; __device__ __forceinline__ float operator()(int k, int n) const { if (n >= 3840) { const int rel = n - 3840; if (rel >= 128) return 0.f; n = 3840 + ((rel >> 5) << 4) + (((rel >> 3) & 3) << 2) + (rel & 3); } return W[(size_t)k * DIN + n]; } };
struct SrcPlain { const float* W; int ld; __device__ __forceinline__ float operator()(int k, int n) const { return W[(size_t)k * ld + n]; } };
struct SrcUq { const float* W; __device__ __forceinline__ float operator()(int k, int n) const { const int h = n / 192, j = n - h * 192;
        const int col = j < 128 ? h * 192 + j : h * 192 + 128 + ((j - 128) >> 1) + 32 * ((j - 128) & 1); return W[(size_t)k * 1536 + col]; } };
struct SrcGU { const float* Wm; const float* g; __device__ __forceinline__ float operator()(int k, int n) const { const int pn = n >> 8, j = n & 127;
        return g[k] * Wm[(size_t)k * DFF + pn * 128 + j]; } };

__device__ __forceinline__ void norm_row_to_bf16(const float* xrow, const float* g, bf16* orow, int lane) {
    GAS unsigned long long* o8 = (GAS unsigned long long*)orow + lane;
    if (!xrow) {
#pragma unroll
        for (int j = 0; j < 8; ++j) o8[64 * j] = 0ull;
        return; }
    const GAS f32x4* xr = (const GAS f32x4*)xrow + lane; const GAS f32x4* gr = (const GAS f32x4*)g + lane;
    f32x4 v[8], gv[8]; float s = 0.f;
#pragma unroll
    for (int j = 0; j < 8; ++j) { v[j] = __builtin_nontemporal_load(xr + 64 * j); gv[j] = gr[64 * j]; }
#pragma unroll
    for (int j = 0; j < 8; ++j) s += (v[j].x * v[j].x + v[j].y * v[j].y) + (v[j].z * v[j].z + v[j].w * v[j].w);
    const float rstd = rsqrt_f(wave_sum(s) * (1.f / DM) + EPS);
#pragma unroll
    for (int j = 0; j < 8; ++j) { const f32x4 gg = gv[j]; o8[64 * j] = (unsigned long long)pk2(v[j].x * rstd * gg.x, v[j].y * rstd * gg.y) | ((unsigned long long)pk2(v[j].z * rstd * gg.z, v[j].w * rstd * gg.w) << 32); }
}
__device__ __forceinline__ void cvt_row1024(const float* src, bf16* dst, int lane) {
    const GAS f32x4* s = (const GAS f32x4*)src + lane; GAS unsigned long long* o8 = (GAS unsigned long long*)dst + lane;
    f32x4 v[4];
#pragma unroll
    for (int j = 0; j < 4; ++j) v[j] = __builtin_nontemporal_load(s + 64 * j);
#pragma unroll
    for (int j = 0; j < 4; ++j) o8[64 * j] = (unsigned long long)pk2(v[j].x, v[j].y) | ((unsigned long long)pk2(v[j].z, v[j].w) << 32);
}
__device__ __forceinline__ void zero_row1024(bf16* dst, int lane) {
    GAS unsigned long long* o8 = (GAS unsigned long long*)dst + lane;
#pragma unroll
    for (int j = 0; j < 4; ++j) o8[64 * j] = 0ull;
}

struct Ptrs {
    const float *x_prompt, *x_sample, *c_dk, *c_dv, *c_ckv, *c_kr, *meta, *rel_bias, *g_attn, *w_in, *lam4, *g_subln, *g_q, *w_uq, *g_kv, *w_ukv, *w_out, *g_ffn, *w_gate, *w_up, *w_down, *g_final;
    float* out; unsigned char* ws;
    bf16 *WinT, *WuqT, *WukvT, *WoutT, *WguT, *WdT, *Qd, *Kd, *Vd, *Vm, *Km, *Qm, *mix, *x2b, *H, *h1, *cqn, *ckvn;
    float *zc, *part2, *part3, *oscr, *slab, *rstd2; f32x2* rope; gu32* ctl; bf16* Kr;
};

struct TrDesc { const float* src; const float* g; bf16* dst; int ld2, valid, K, k0, n0; };
__device__ __forceinline__ TrDesc tr_decode0(const Ptrs& P, int it, int lane) {
    constexpr int I_IN = (DM / 64) * (DINP / 32), I_UQ = (QLORA / 64) * (1536 / 32), I_UKV = (KVLORA / 64) * (2048 / 32);
    TrDesc d; int r = it; const int ln = lane & 31, lk = lane >> 5; d.g = nullptr; d.valid = 1;
    if (r < I_IN) { const int nb = DINP / 32; d.k0 = 64 * (r / nb); d.n0 = 32 * (r % nb);   d.valid = d.n0 < 3968; int col_ = d.n0 + ln; if (d.n0 >= 3840) { const int rel = col_ - 3840; col_ = 3840 + ((rel >> 5) << 4) + (((rel >> 3) & 3) << 2) + (rel & 3); } d.src = P.w_in + (size_t)(d.k0 + lk) * DIN + (d.valid ? col_ : 0); d.ld2 = 2 * DIN; d.dst = P.WinT; d.K = DM; return d; } r -= I_IN;
    if (r < I_UQ) { const int nb = 1536 / 32; d.k0 = 64 * (r / nb); d.n0 = 32 * (r % nb); const int n = d.n0 + ln, h = n / 192, j = n - h * 192;
        const int col = j < 128 ? h * 192 + j : h * 192 + 128 + ((j - 128) >> 1) + 32 * ((j - 128) & 1);
        d.src = P.w_uq + (size_t)(d.k0 + lk) * 1536 + col; d.ld2 = 2 * 1536; d.dst = P.WuqT; d.K = QLORA; return d; } r -= I_UQ;
    if (r < I_UKV) { const int nb = 2048 / 32; d.k0 = 64 * (r / nb); d.n0 = 32 * (r % nb); d.src = P.w_ukv + (size_t)(d.k0 + lk) * 2048 + d.n0 + ln; d.ld2 = 2 * 2048; d.dst = P.WukvT; d.K = KVLORA; return d; } r -= I_UKV;
    { const int nb = 2 * DFF / 32; d.k0 = 64 * (r / nb); d.n0 = 32 * (r % nb); const int n = d.n0 + ln; const float* Wm = P.w_gate; if ((d.n0 >> 7) & 1) Wm = P.w_up;
      d.src = Wm + (size_t)(d.k0 + lk) * DFF + (n >> 8) * 128 + (n & 127); d.ld2 = 2 * DFF; d.g = P.g_ffn + d.k0; d.dst = P.WguT; d.K = DM; return d; }
}
__device__ __forceinline__ void tr_load(const TrDesc& d, float (&v)[32]) {
    if (d.valid) {
#pragma unroll
        for (int i = 0; i < 32; ++i) v[i] = __builtin_nontemporal_load(d.src + (size_t)i * d.ld2);
    } else {
#pragma unroll
        for (int i = 0; i < 32; ++i) v[i] = 0.f;
    }
}
__device__ __forceinline__ void tr_process(const TrDesc& d, const float (&v)[32], LAS float* scr, int lane) {
#pragma unroll
    for (int i = 0; i < 32; ++i) scr[(2 * i + (lane >> 5)) * 33 + (lane & 31)] = v[i];
    LDS_WAIT(); asm volatile("" ::: "memory");
    const int c = lane & 7;
    f32x4 g0 = {1.f, 1.f, 1.f, 1.f}, g1 = {1.f, 1.f, 1.f, 1.f};
    if (d.g) { g0 = *(const GAS f32x4*)(d.g + 8 * c); g1 = *(const GAS f32x4*)(d.g + 8 * c + 4); }
#pragma unroll
    for (int j = 0; j < 4; ++j) { const int n = (lane >> 3) + 8 * j; const LAS float* s = scr + (8 * c) * 33 + n;
        v4u o; o.x = pk2(s[0 * 33] * g0.x, s[1 * 33] * g0.y); o.y = pk2(s[2 * 33] * g0.z, s[3 * 33] * g0.w); o.z = pk2(s[4 * 33] * g1.x, s[5 * 33] * g1.y); o.w = pk2(s[6 * 33] * g1.z, s[7 * 33] * g1.w);
        *(GAS v4u*)(d.dst + (size_t)(d.n0 + n) * d.K + d.k0 + 8 * c) = o; }
    LDS_WAIT(); asm volatile("" ::: "memory");
}
__device__ __forceinline__ void convert_list0_pipelined(const Ptrs& P, LAS float* scr, int w, int NW, int lane) {
    constexpr int NI = (DM / 64) * (DINP / 32) + (QLORA / 64) * (1536 / 32) + (KVLORA / 64) * (2048 / 32) + (DM / 64) * (2 * DFF / 32);
    int it = w; if (it >= NI) return;
    TrDesc cur = tr_decode0(P, it, lane); float va[32], vb[32]; tr_load(cur, va);
    for (;;) {
        const int itn = it + NW; const bool more = itn < NI; TrDesc nxt = cur;
        if (more) { nxt = tr_decode0(P, itn, lane); tr_load(nxt, vb); }
        tr_process(cur, va, scr, lane);
        if (!more) break;
        cur = nxt; it = itn;
#pragma unroll
        for (int i = 0; i < 32; ++i) va[i] = vb[i];
    }
}

__device__ __forceinline__ void convert_weights(const Ptrs& P, LAS float* scr, int list, int w, int NW, int lane) {
    constexpr int I_IN = (DM / 64) * (DINP / 32), I_UQ = (QLORA / 64) * (1536 / 32), I_UKV = (KVLORA / 64) * (2048 / 32), I_OUT = (DM / 64) * (DM / 32), I_GU = (DM / 64) * (2 * DFF / 32), I_D = (DFF / 64) * (DM / 32);
    if (list == 0) {
        for (int it = w; it < I_IN + I_UQ + I_UKV + I_GU; it += NW) {
            int r = it;
            if (r < I_IN) { const int nb = DINP / 32; tr_item(SrcIn{P.w_in}, DM, P.WinT, 64 * (r / nb), 32 * (r % nb), scr, lane); continue; } r -= I_IN;
            if (r < I_UQ) { const int nb = 1536 / 32; tr_item(SrcUq{P.w_uq}, QLORA, P.WuqT, 64 * (r / nb), 32 * (r % nb), scr, lane); continue; } r -= I_UQ;
            if (r < I_UKV) { const int nb = 2048 / 32; tr_item(SrcPlain{P.w_ukv, 2048}, KVLORA, P.WukvT, 64 * (r / nb), 32 * (r % nb), scr, lane); continue; } r -= I_UKV;
            { const int nb = 2 * DFF / 32, n0 = 32 * (r % nb); const float* Wm = P.w_gate; if ((n0 >> 7) & 1) Wm = P.w_up;
              tr_item(SrcGU{Wm, P.g_ffn}, DM, P.WguT, 64 * (r / nb), n0, scr, lane); }
        }
    } else if (list == 1) {
        for (int r = w; r < I_OUT; r += NW) { const int nb = DM / 32; tr_item(SrcPlain{P.w_out, DM}, DM, P.WoutT, 64 * (r / nb), 32 * (r % nb), scr, lane); }
    } else {
        for (int r = w; r < I_D; r += NW) { const int nb = DM / 32; tr_item(SrcPlain{P.w_down, DM}, DFF, P.WdT, 64 * (r / nb), 32 * (r % nb), scr, lane); }
    }
}
__device__ __forceinline__ void p0_prologue(const Ptrs& P, LAS unsigned char* lds, int gw, int NGW, int wave, int lane) {
    LAS float* scr = (LAS float*)(lds + wave * 16384);
    convert_list0_pipelined(P, scr, gw, NGW, lane);
    { const GAS f32x4* gr = (const GAS f32x4*)P.g_attn + lane; f32x4 gv[8];
#pragma unroll
      for (int j = 0; j < 8; ++j) gv[j] = gr[64 * j];
      for (int m0 = gw; m0 < MP; m0 += 4 * NGW) {
        f32x4 v[4][8];
#pragma unroll
        for (int q = 0; q < 4; ++q) { const int m = m0 + q * NGW;
            const float* src = m < RP ? P.x_prompt + (size_t)m * DM : m < R ? P.x_sample + (size_t)(m - RP) * DM : m < R + NMETA ? P.meta + (size_t)(m - R) * DM : nullptr;
            if (src) {
#pragma unroll
                for (int j = 0; j < 8; ++j) v[q][j] = __builtin_nontemporal_load((const GAS f32x4*)src + lane + 64 * j);
            } else {
#pragma unroll
                for (int j = 0; j < 8; ++j) v[q][j] = (f32x4){0.f, 0.f, 0.f, 0.f};
            } }
#pragma unroll
        for (int q = 0; q < 4; ++q) { const int m = m0 + q * NGW;
            if (m < MP) { float s_ = 0.f;
#pragma unroll
                for (int j = 0; j < 8; ++j) s_ += (v[q][j].x * v[q][j].x + v[q][j].y * v[q][j].y) + (v[q][j].z * v[q][j].z + v[q][j].w * v[q][j].w);
                const float rstd = rsqrt_f(wave_sum(s_) * (1.f / DM) + EPS);
                GAS unsigned long long* o8 = (GAS unsigned long long*)(P.h1 + (size_t)m * DM) + lane;
#pragma unroll
                for (int j = 0; j < 8; ++j) { const f32x4 gg = gv[j], x = v[q][j]; o8[64 * j] = (unsigned long long)pk2(x.x * rstd * gg.x, x.y * rstd * gg.y) | ((unsigned long long)pk2(x.z * rstd * gg.z, x.w * rstd * gg.w) << 32); } } }
      } }
    for (int m0 = gw; m0 < DB * PAST; m0 += 4 * NGW) {
        f32x4 ck[4][4], cv[4][4];
#pragma unroll
        for (int q = 0; q < 4; ++q) { const int m = (m0 + q * NGW < DB * PAST) ? m0 + q * NGW : m0; const GAS f32x4* sk = (const GAS f32x4*)(P.c_dk + (size_t)m * 1024) + lane; const GAS f32x4* sv = (const GAS f32x4*)(P.c_dv + (size_t)m * 1024) + lane;
#pragma unroll
            for (int j = 0; j < 4; ++j) { ck[q][j] = __builtin_nontemporal_load(sk + 64 * j); cv[q][j] = __builtin_nontemporal_load(sv + 64 * j); } }
#pragma unroll
        for (int q = 0; q < 4; ++q) { const int m = m0 + q * NGW;
            if (m < DB * PAST) { const int b = m >> 10, j_ = m & 1023; const size_t krow = (size_t)KVP + (size_t)b * LS + j_;
                GAS unsigned long long* ok = (GAS unsigned long long*)(P.Kd + krow * 1024) + lane; GAS unsigned long long* ov = (GAS unsigned long long*)(P.Vd + krow * 1024) + lane;
#pragma unroll
                for (int j = 0; j < 4; ++j) { ok[64 * j] = (unsigned long long)pk2(ck[q][j].x, ck[q][j].y) | ((unsigned long long)pk2(ck[q][j].z, ck[q][j].w) << 32);
                                              ov[64 * j] = (unsigned long long)pk2(cv[q][j].x, cv[q][j].y) | ((unsigned long long)pk2(cv[q][j].z, cv[q][j].w) << 32); } } }
    }
    for (int m = gw; m < NB * 48; m += NGW) { const size_t krow = (size_t)(m / 48) * KPB + 16 + (m % 48); zero_row1024(P.Kd + krow * 1024, lane); zero_row1024(P.Vd + krow * 1024, lane); }
    for (int e = gw * 64 + lane; e < LP * 32; e += NGW * 64) { const int pos = e >> 5, i = e & 31;
        const float invf = exp2f(-(float)i * (13.287712379549449f / 32.0f)); const float ang = (float)pos * invf;
        const double rev = (double)ang * 0.15915494309189535; const float fr = (float)(rev - floor(rev));
        P.rope[e] = (f32x2){__builtin_amdgcn_cosf(fr), __builtin_amdgcn_sinf(fr)}; }
}

struct P2Row { f32x4 qa, qb, ca; float xv; f32x2 cs; };
__device__ __forceinline__ int p2_pos(int m) { return m < RP ? NMETA + (m & 4095) : m < R ? PAST + ((m - RP) & 63) : m - R; }
__device__ __forceinline__ P2Row p2_load(const Ptrs& P, int m, int lane) {
    const bf16* z = (const bf16*)P.zc + (size_t)m * ZC; P2Row r;
    const u32x2 wa_ = __builtin_nontemporal_load((const GAS u32x2*)z + lane), wb_ = __builtin_nontemporal_load((const GAS u32x2*)z + 64 + lane), wc_ = __builtin_nontemporal_load((const GAS u32x2*)(z + QLORA) + lane);
    const unsigned short wx_ = __builtin_nontemporal_load((const GAS unsigned short*)(z + QLORA + KVLORA) + lane);
    r.qa = (f32x4){__uint_as_float(wa_.x << 16), __uint_as_float(wa_.x & 0xffff0000u), __uint_as_float(wa_.y << 16), __uint_as_float(wa_.y & 0xffff0000u)};
    r.qb = (f32x4){__uint_as_float(wb_.x << 16), __uint_as_float(wb_.x & 0xffff0000u), __uint_as_float(wb_.y << 16), __uint_as_float(wb_.y & 0xffff0000u)};
    r.ca = (f32x4){__uint_as_float(wc_.x << 16), __uint_as_float(wc_.x & 0xffff0000u), __uint_as_float(wc_.y << 16), __uint_as_float(wc_.y & 0xffff0000u)};
    r.xv = __uint_as_float((unsigned)wx_ << 16); r.cs = P.rope[(size_t)p2_pos(m) * 32 + (lane & 31)]; return r;
}
__device__ __forceinline__ void p2_process(const Ptrs& P, int m, const P2Row& rw, const f32x4& gq0, const f32x4& gq1, const f32x4& gkv, int lane) {
    int ncopy; size_t krow, orow_ckv, orow_kr;
    if (m < RP) { const int b = m >> 12, t = m & 4095; ncopy = 1; krow = (size_t)b * KPB + 64 + t; orow_ckv = O_CKVP + ((size_t)b * LP + NMETA + t) * 256; orow_kr = O_KRP + ((size_t)b * LP + NMETA + t) * 64; }
    else if (m < R) { const int rr = m - RP, b = rr >> 6, j = rr & 63; ncopy = 1; krow = (size_t)KVP + (size_t)b * LS + PAST + j; orow_ckv = O_CKVS + (size_t)rr * 256; orow_kr = O_KRS + (size_t)rr * 64; }
    else { const int mm = m - R; ncopy = NB; krow = mm; orow_ckv = O_CKVP + (size_t)mm * 256; orow_kr = O_KRP + (size_t)mm * 64; }
    const f32x4 qa = rw.qa, qb = rw.qb, ca = rw.ca; const float xv = rw.xv; const f32x2 cs = rw.cs;
    if (m < R) {
        const float ss = wave_sum((qa.x * qa.x + qa.y * qa.y) + (qa.z * qa.z + qa.w * qa.w) + (qb.x * qb.x + qb.y * qb.y) + (qb.z * qb.z + qb.w * qb.w));
        const float rstd = rsqrt_f(ss * (1.f / QLORA) + EPS);
        GAS u32x2* o = (GAS u32x2*)(P.cqn + (size_t)m * QLORA);
        o[lane] = (u32x2){pk2(qa.x * rstd * gq0.x, qa.y * rstd * gq0.y), pk2(qa.z * rstd * gq0.z, qa.w * rstd * gq0.w)};
        o[64 + lane] = (u32x2){pk2(qb.x * rstd * gq1.x, qb.y * rstd * gq1.y), pk2(qb.z * rstd * gq1.z, qb.w * rstd * gq1.w)}; }
    { const float ss = wave_sum((ca.x * ca.x + ca.y * ca.y) + (ca.z * ca.z + ca.w * ca.w));
        const float rstd = rsqrt_f(ss * (1.f / KVLORA) + EPS);
        const f32x4 v = {ca.x * rstd * gkv.x, ca.y * rstd * gkv.y, ca.z * rstd * gkv.z, ca.w * rstd * gkv.w}; const u32x2 w = {pk2(v.x, v.y), pk2(v.z, v.w)};
        for (int c = 0; c < ncopy; ++c) { __builtin_nontemporal_store(v, (GAS f32x4*)(P.out + orow_ckv + (size_t)c * LP * 256) + lane); ((GAS u32x2*)(P.ckvn + (krow + (size_t)c * KPB) * KVLORA))[lane] = w; } }
    { const float xo = __shfl_xor(xv, 32);
        const float v = lane < 32 ? xv * cs.x - xo * cs.y : xo * cs.y + xv * cs.x; const bf16 vb = (bf16)f2bf(v);
        for (int c = 0; c < ncopy; ++c) { __builtin_nontemporal_store(v, P.out + orow_kr + (size_t)c * LP * 64 + lane); P.Kr[(krow + (size_t)c * KPB) * ROPE + lane] = vb; } }
}
__device__ __forceinline__ void p2_rows(const Ptrs& P, int gw, int NGW, int lane) {
    const f32x4 gq0 = ((const GAS f32x4*)P.g_q)[lane], gq1 = ((const GAS f32x4*)P.g_q)[64 + lane], gkv = ((const GAS f32x4*)P.g_kv)[lane];
    for (int m0 = gw; m0 < R + NMETA; m0 += 4 * NGW) {
        P2Row rw[4];
#pragma unroll
        for (int j = 0; j < 4; ++j) { const int m = m0 + j * NGW; rw[j] = p2_load(P, m < R + NMETA ? m : m0, lane); }
#pragma unroll
        for (int j = 0; j < 4; ++j) { const int m = m0 + j * NGW; if (m < R + NMETA) p2_process(P, m, rw[j], gq0, gq1, gkv, lane); }
    }
    for (int m0 = gw; m0 < DB * PAST; m0 += 4 * NGW) {
        f32x4 a[4]; float kr_[4];
#pragma unroll
        for (int j = 0; j < 4; ++j) { const int m = (m0 + j * NGW < DB * PAST) ? m0 + j * NGW : m0; a[j] = __builtin_nontemporal_load((const GAS f32x4*)(P.c_ckv + (size_t)m * KVLORA) + lane); kr_[j] = __builtin_nontemporal_load(P.c_kr + (size_t)m * ROPE + lane); }
#pragma unroll
        for (int j = 0; j < 4; ++j) { const int m = m0 + j * NGW; if (m < DB * PAST) { const int b = m >> 10, jj = m & 1023; const size_t krow = (size_t)KVP + (size_t)b * LS + jj;
            ((GAS u32x2*)(P.ckvn + krow * KVLORA))[lane] = (u32x2){pk2(a[j].x, a[j].y), pk2(a[j].z, a[j].w)};
            P.Kr[krow * ROPE + lane] = (bf16)f2bf(kr_[j]); } }
    }
    for (int m = gw; m < NB * 48; m += NGW) { const size_t krow = (size_t)(m / 48) * KPB + 16 + (m % 48);
        ((GAS u32x2*)(P.ckvn + krow * KVLORA))[lane] = (u32x2){0u, 0u}; P.Kr[krow * ROPE + lane] = 0; }
}

__device__ __forceinline__ void p6_pre(const Ptrs& P, int gw, int NGW, int lane) {
    for (int m = gw; m < RS; m += NGW) { const int pmx = m >> 8, rit = m & 255; const size_t r = (size_t)RP + m; float ss = 0.f;
        f32x4 v[8];
#pragma unroll
        for (int j = 0; j < 8; ++j) { f32x4 a = __builtin_nontemporal_load((const GAS f32x4*)(P.x_sample + (size_t)m * DM) + 64 * j + lane);
            const bf16* sl = (const bf16*)P.slab + (size_t)((pmx * 8 + j) * epi::NSPLIT_OUT) * 65536 + (size_t)rit * 256 + 4 * lane;
#pragma unroll
            for (int ks = 0; ks < epi::NSPLIT_OUT; ++ks) { const u32x2 w_ = __builtin_nontemporal_load((const GAS u32x2*)(sl + (size_t)ks * 65536));
                a += (f32x4){__uint_as_float(w_.x << 16), __uint_as_float(w_.x & 0xffff0000u), __uint_as_float(w_.y << 16), __uint_as_float(w_.y & 0xffff0000u)}; }
            v[j] = a; ss += (a.x * a.x + a.y * a.y) + (a.z * a.z + a.w * a.w);
            if (j == 3) __builtin_amdgcn_sched_barrier(0); }
#pragma unroll
        for (int j = 0; j < 8; ++j) ((GAS u32x2*)(P.x2b + r * DM))[64 * j + lane] = (u32x2){pk2(v[j].x, v[j].y), pk2(v[j].z, v[j].w)};
        ss = wave_sum(ss);
        if (lane == 0) P.rstd2[r] = rsqrt_f(ss * (1.f / DM) + EPS); }
    for (int r = (NGW - 1 - gw) * 64 + lane; r < RP; r += NGW * 64) { const GAS f32x4* pp = (const GAS f32x4*)(P.part2 + (size_t)r * 32); f32x4 s4 = pp[0];
#pragma unroll
        for (int i = 1; i < 8; ++i) s4 += pp[i];
        P.rstd2[r] = rsqrt_f(((s4.x + s4.y) + (s4.z + s4.w)) * (1.f / DM) + EPS); }
}
__device__ __forceinline__ void p8_final(const Ptrs& P, int gw, int NGW, int lane) {
    for (int m = gw; m < RS; m += NGW) { const int pmx = m >> 8, rit = m & 255; const size_t r = (size_t)RP + m; float ss = 0.f;
        GAS f32x4* xr = (GAS f32x4*)(P.out + r * DM) + lane; const GAS f32x4* gr = (const GAS f32x4*)P.g_final + lane;
        f32x4 v[8];
#pragma unroll
        for (int j = 0; j < 8; ++j) { const u32x2 w = __builtin_nontemporal_load((const GAS u32x2*)(P.x2b + r * DM) + 64 * j + lane);
            f32x4 a = (f32x4){__uint_as_float(w.x << 16), __uint_as_float(w.x & 0xffff0000u), __uint_as_float(w.y << 16), __uint_as_float(w.y & 0xffff0000u)};
            const bf16* sl = (const bf16*)P.slab + (size_t)((pmx * 8 + j) * epi::NSPLIT_DOWN) * 65536 + (size_t)rit * 256 + 4 * lane;
#pragma unroll
            for (int ks = 0; ks < epi::NSPLIT_DOWN; ++ks) { const u32x2 w_ = __builtin_nontemporal_load((const GAS u32x2*)(sl + (size_t)ks * 65536));
                a += (f32x4){__uint_as_float(w_.x << 16), __uint_as_float(w_.x & 0xffff0000u), __uint_as_float(w_.y << 16), __uint_as_float(w_.y & 0xffff0000u)}; }
            v[j] = a; ss += (a.x * a.x + a.y * a.y) + (a.z * a.z + a.w * a.w);
            if (j & 1) __builtin_amdgcn_sched_barrier(0); }
        const float rstd = rsqrt_f(wave_sum(ss) * (1.f / DM) + EPS);
        f32x4 g[8];
#pragma unroll
        for (int j = 0; j < 8; ++j) g[j] = gr[64 * j];
#pragma unroll
        for (int j = 0; j < 8; ++j) __builtin_nontemporal_store((f32x4){v[j].x * rstd * g[j].x, v[j].y * rstd * g[j].y, v[j].z * rstd * g[j].z, v[j].w * rstd * g[j].w}, xr + 64 * j); }
    f32x4 gg[4][2];
#pragma unroll
    for (int q = 0; q < 4; ++q) { gg[q][0] = ((const GAS f32x4*)P.g_final)[2 * (64 * q + lane)]; gg[q][1] = ((const GAS f32x4*)P.g_final)[2 * (64 * q + lane) + 1]; }
    for (int m0 = gw; m0 < RP; m0 += 2 * NGW) {
        const int m1 = (m0 + NGW < RP) ? m0 + NGW : m0;
        const GAS f32x4* pa = (const GAS f32x4*)(P.part3 + (size_t)m0 * 32); const GAS f32x4* pb = (const GAS f32x4*)(P.part3 + (size_t)m1 * 32);
        const GAS v4u* xa = (const GAS v4u*)(P.x2b + (size_t)m0 * DM) + lane; const GAS v4u* xb = (const GAS v4u*)(P.x2b + (size_t)m1 * DM) + lane;
        v4u wa[4], wb[4]; f32x4 sa4 = pa[0], sb4 = pb[0];
#pragma unroll
        for (int q = 0; q < 4; ++q) { wa[q] = xa[64 * q]; wb[q] = xb[64 * q]; }
#pragma unroll
        for (int i = 1; i < 8; ++i) { sa4 += pa[i]; sb4 += pb[i]; }
        const float ra = rsqrt_f(((sa4.x + sa4.y) + (sa4.z + sa4.w)) * (1.f / DM) + EPS), rb = rsqrt_f(((sb4.x + sb4.y) + (sb4.z + sb4.w)) * (1.f / DM) + EPS);
        GAS f32x4* ya = (GAS f32x4*)(P.out + (size_t)m0 * DM) + 2 * lane; GAS f32x4* yb = (GAS f32x4*)(P.out + (size_t)m1 * DM) + 2 * lane;
#define P8_LO(u) __uint_as_float((u) << 16)
#define P8_HI(u) __uint_as_float((u) & 0xffff0000u)
#pragma unroll
        for (int q = 0; q < 4; ++q) {
            __builtin_nontemporal_store((f32x4){P8_LO(wa[q].x) * ra * gg[q][0].x, P8_HI(wa[q].x) * ra * gg[q][0].y, P8_LO(wa[q].y) * ra * gg[q][0].z, P8_HI(wa[q].y) * ra * gg[q][0].w}, ya + 128 * q);
            __builtin_nontemporal_store((f32x4){P8_LO(wa[q].z) * ra * gg[q][1].x, P8_HI(wa[q].z) * ra * gg[q][1].y, P8_LO(wa[q].w) * ra * gg[q][1].z, P8_HI(wa[q].w) * ra * gg[q][1].w}, ya + 128 * q + 1);
            __builtin_nontemporal_store((f32x4){P8_LO(wb[q].x) * rb * gg[q][0].x, P8_HI(wb[q].x) * rb * gg[q][0].y, P8_LO(wb[q].y) * rb * gg[q][0].z, P8_HI(wb[q].y) * rb * gg[q][0].w}, yb + 128 * q);
            __builtin_nontemporal_store((f32x4){P8_LO(wb[q].z) * rb * gg[q][1].x, P8_HI(wb[q].z) * rb * gg[q][1].y, P8_LO(wb[q].w) * rb * gg[q][1].z, P8_HI(wb[q].w) * rb * gg[q][1].w}, yb + 128 * q + 1); }
#undef P8_LO
#undef P8_HI
    }
}
namespace att {
typedef short s16x4 __attribute__((ext_vector_type(4)));
typedef float f32x16 __attribute__((ext_vector_type(16)));
typedef unsigned u32x4 __attribute__((ext_vector_type(4)));
typedef short v4i16_t __attribute__((ext_vector_type(4)));
typedef LAS const unsigned char* lds_cptr;
constexpr int SLOT_K = 24576, SLOT_V = 16384, LDS_K = 0, LDS_V = 3 * SLOT_K, LDS_BT = LDS_V + 3 * SLOT_V, LDS_WS = LDS_BT + 1536, LDS_Q = LDS_WS + NWAVES * 256, LDS_QS = LDS_Q + 64, LDS_END = LDS_QS + NWAVES * 4096;
static_assert(LDS_END <= LDSCTL_OFF, "attention LDS map");
constexpr int NUNITS = 1024 + 128;
__device__ __forceinline__ int crow(int r, int hi) { return (r & 3) + 8 * (r >> 2) + 4 * hi; }
__device__ __forceinline__ void glds16(const void* gsrc, unsigned lds_dst) { unsigned keep;
    asm volatile("s_mov_b32 %0, m0\n\ts_mov_b32 m0, %2\n\ts_nop 0\n\tglobal_load_lds_dwordx4 %1, off\n\ts_mov_b32 m0, %0" : "=&s"(keep) : "v"(gsrc), "s"(lds_dst) : "memory"); }
typedef float f32x2_t __attribute__((ext_vector_type(2))); typedef __bf16 bf16x2_t __attribute__((ext_vector_type(2)));
__device__ __forceinline__ unsigned cvtpk_s(float lo, float hi) { f32x2_t v = {lo, hi}; bf16x2_t b = __builtin_convertvector(v, bf16x2_t); return __builtin_bit_cast(unsigned, b); }
__device__ __forceinline__ s16x4 vtr(lds_cptr p) { return __builtin_bit_cast(s16x4, __builtin_amdgcn_ds_read_tr16_b64_v4i16((LAS v4i16_t*)p)); }
__device__ __forceinline__ float max3f(float a, float b, float c) { float r; asm("v_max3_f32 %0, %1, %2, %3" : "=v"(r) : "v"(a), "v"(b), "v"(c)); return r; }
__device__ __forceinline__ float max2f(float a, float b) { float r; asm("v_max_f32_e32 %0, %1, %2" : "=v"(r) : "v"(a), "v"(b)); return r; }
__device__ __forceinline__ float fadd_s(float a, float b) { float r; asm("v_add_f32_e32 %0, %1, %2" : "=v"(r) : "v"(a), "v"(b)); return r; }
__device__ __forceinline__ float fsub_s(float a, float b) { float r; asm("v_sub_f32_e32 %0, %1, %2" : "=v"(r) : "v"(a), "v"(b)); return r; }
#define ATT_WAITBAR(N) asm volatile("s_waitcnt vmcnt(" #N ") lgkmcnt(0)\n\ts_barrier" ::: "memory")

template <int DQK>
__device__ __forceinline__ void attn_pass(f32x16 (&o)[4], const bf16* Qw, int qstride, const bf16* Kh, int kstride, const bf16* Vh, int vstride,
                                          int NT, int wnt, bool bias, bool prompt, int qpos0, LAS unsigned char* shm, int lane, int wid, unsigned* shm_ctl_probe = nullptr, const bf16* Krh = nullptr) {
    constexpr int KP = DQK / 64, ND0 = DQK / 16;
    constexpr bool USE_NEGM = (DQK == 64);
    const int r32 = lane & 31, hi = lane >> 5;
    const unsigned lds0 = (unsigned)(uintptr_t)shm;
    LAS float* wsf = (LAS float*)(shm + LDS_WS) + wid * 64;
    const LAS float* btab = (const LAS float*)(shm + LDS_BT);
    const bf16* ksrc = Kh + (size_t)lane * kstride + wid * 8;
    const bf16* krsrc = Krh + (size_t)lane * 64 + wid * 8;
    const bf16* vsrc = Vh + (size_t)(16 * (wid & 3) + (lane >> 2)) * vstride + (wid >> 2) * 32 + (lane & 3) * 8;
    const unsigned kdst = lds0 + LDS_K + wid * 1024, vdst = lds0 + LDS_V + wid * 1024;
#define ATT_DMA(t, slot) do { const bf16* ks_ = ksrc + (size_t)(t) * 64 * kstride; const bf16* vs_ = vsrc + (size_t)(t) * 64 * vstride; const bf16* kr_ = krsrc + (size_t)(t) * 64 * 64; \
        _Pragma("unroll") for (int i_ = 0; i_ < KP; ++i_) glds16((DQK == 192 && i_ == 2) ? kr_ : ks_ + i_ * 64, (unsigned)__builtin_amdgcn_readfirstlane(kdst + (slot) * SLOT_K + i_ * 8192)); \
        _Pragma("unroll") for (int i_ = 0; i_ < 2; ++i_) glds16(vs_ + i_ * 64, (unsigned)__builtin_amdgcn_readfirstlane(vdst + (slot) * SLOT_V + i_ * 8192)); } while (0)
    ATT_DMA(0, 0); if (NT > 1) ATT_DMA(1, 1);
    constexpr int NQR = (DQK == 64) ? ND0 : 8;
    bf16x8 qr[NQR];
    const lds_cptr qs = (lds_cptr)shm + LDS_QS + wid * 4096 + lane * 16;
    if (wnt > 0) {
#pragma unroll
        for (int d0 = 0; d0 < NQR; ++d0) qr[d0] = *(const bf16x8*)(Qw + (size_t)r32 * qstride + d0 * 16 + hi * 8);
#pragma unroll
        for (int d0 = NQR; d0 < ND0; ++d0) *(LAS bf16x8*)(qs + (d0 - NQR) * 1024) = *(const bf16x8*)(Qw + (size_t)r32 * qstride + d0 * 16 + hi * 8);
    } else {
#pragma unroll
        for (int d0 = 0; d0 < NQR; ++d0) qr[d0] = (bf16x8){0, 0, 0, 0, 0, 0, 0, 0};
    }
    float mref = 0.f, l = 0.f; f32x16 negm = f32x16{};
#pragma unroll
    for (int d = 0; d < 4; ++d) o[d] = f32x16{};
    int s_cur = 0, s_n2 = 2;
    const bool g1 = wid >= 4;
#if defined(PROBE_ATT_SEG)
    unsigned pw_acc = 0;
#define ATT_WB_TILE(more) do { if (more) { if (KP == 1) ATT_WAITBAR(3); else ATT_WAITBAR(5); } else ATT_WAITBAR(0); } while (0)
#define ATT_BAR() asm volatile("s_waitcnt lgkmcnt(0)\n\ts_barrier" ::: "memory")
#elif defined(PROBE_ATT_WAIT)
    unsigned pw_acc = 0;
#define ATT_WB_TILE(more) do { const unsigned long long w0_ = __builtin_amdgcn_s_memtime(); if (more) { if (KP == 1) ATT_WAITBAR(3); else ATT_WAITBAR(5); } else ATT_WAITBAR(0); pw_acc += (unsigned)(__builtin_amdgcn_s_memtime() - w0_); } while (0)
#define ATT_BAR() do { const unsigned long long w0_ = __builtin_amdgcn_s_memtime(); asm volatile("s_waitcnt lgkmcnt(0)\n\ts_barrier" ::: "memory"); pw_acc += (unsigned)(__builtin_amdgcn_s_memtime() - w0_); } while (0)
#else
#define ATT_WB_TILE(more) do { if (more) { if (KP == 1) ATT_WAITBAR(3); else ATT_WAITBAR(5); } else ATT_WAITBAR(0); } while (0)
#define ATT_BAR() asm volatile("s_waitcnt lgkmcnt(0)\n\ts_barrier" ::: "memory")
#endif
    if (g1) ATT_WB_TILE(NT > 1);
    f32x16 p0, p1;
    s16x4 va[8], vb[8];
#define ATT_LDVK(dst, ks) do { _Pragma("unroll") for (int d_ = 0; d_ < 4; ++d_) { dst[2 * d_] = vtr(vp + d_ * 4096 + (ks) * 1024); dst[2 * d_ + 1] = vtr(vp + d_ * 4096 + (ks) * 1024 + 512); } } while (0)
    for (int t = 0; t < NT; ++t) {
        const lds_cptr vp = (lds_cptr)shm + LDS_V + s_cur * SLOT_V + ((lane >> 4) & 1) * 32 + (lane & 3) * 8 + (4 * hi + ((lane & 15) >> 2)) * 64;
        if (!g1) ATT_WB_TILE(t + 1 < NT); else ATT_BAR();
#if defined(PROBE_ATT_SEG)
        const unsigned long long sg0_ = __builtin_amdgcn_s_memtime(); unsigned long long sgm2_ = sg0_;
#endif
        if (t < wnt) {
            const lds_cptr kp = (lds_cptr)shm + LDS_K + s_cur * SLOT_K + hi * 1024 + r32 * 16;
            constexpr int GD = (DQK == 64) ? 2 : 1, NG = ND0 / GD;
            bf16x8 ka[2 * GD], kb[2 * GD], qta, qtb;
#define ATT_QF(g, qt) ((GD * (g)) < NQR ? qr[(GD * (g)) < NQR ? (GD * (g)) : 0] : qt)
#define ATT_LDK(dst, qt, g) do { _Pragma("unroll") for (int j_ = 0; j_ < GD; ++j_) { dst[2 * j_] = *(const LAS bf16x8*)(kp + (GD * (g) + j_) * 2048); dst[2 * j_ + 1] = *(const LAS bf16x8*)(kp + (GD * (g) + j_) * 2048 + 512); } \
        if (GD * (g) >= NQR) qt = *(const LAS bf16x8*)(qs + (GD * (g) - NQR) * 1024); } while (0)
#define ATT_MMK(src, qt, g) do { _Pragma("unroll") for (int j_ = 0; j_ < GD; ++j_) { const int d0_ = GD * (g) + j_; const bf16x8 qf_ = (d0_ < NQR) ? qr[d0_ < NQR ? d0_ : 0] : qt; \
        if (d0_ == 0) { if (USE_NEGM) { p0 = __builtin_amdgcn_mfma_f32_32x32x16_bf16(src[0], qf_, negm, 0, 0, 0); p1 = __builtin_amdgcn_mfma_f32_32x32x16_bf16(src[1], qf_, negm, 0, 0, 0); } \
                        else { p0 = __builtin_amdgcn_mfma_f32_32x32x16_bf16(src[0], qf_, f32x16{}, 0, 0, 0); p1 = __builtin_amdgcn_mfma_f32_32x32x16_bf16(src[1], qf_, f32x16{}, 0, 0, 0); } } \
        else { p0 = __builtin_amdgcn_mfma_f32_32x32x16_bf16(src[2 * j_], qf_, p0, 0, 0, 0); p1 = __builtin_amdgcn_mfma_f32_32x32x16_bf16(src[2 * j_ + 1], qf_, p1, 0, 0, 0); } } } while (0)
            ATT_LDK(ka, qta, 0); ATT_LDK(kb, qtb, 1); __builtin_amdgcn_sched_barrier(0);
#pragma unroll
            for (int g = 0; g < NG; g += 2) { ATT_MMK(ka, qta, g); if (g + 2 < NG) ATT_LDK(ka, qta, g + 2); __builtin_amdgcn_sched_barrier(0); ATT_MMK(kb, qtb, g + 1); if (g + 3 < NG) ATT_LDK(kb, qtb, g + 3); __builtin_amdgcn_sched_barrier(0); }
#undef ATT_LDK
#undef ATT_MMK
#undef ATT_QF
        }
        if (g1 && t + 2 < NT) ATT_DMA(t + 2, s_n2);
        if (t < wnt) {
            asm volatile("s_nop 15\n\ts_nop 7" : "+v"(p0), "+v"(p1));
#if defined(PROBE_ATT_SEG)
            const unsigned long long sgm_ = __builtin_amdgcn_s_memtime(); if (PROBE_ATT_SEG == 2) pw_acc += (unsigned)(sgm_ - sg0_); sgm2_ = sgm_;
#endif
            if (!USE_NEGM && t > 0) {
#pragma unroll
                for (int r = 0; r < 16; ++r) { p0[r] = fsub_s(p0[r], mref); p1[r] = fsub_s(p1[r], mref); } }
            if (bias) { const int kp0 = prompt ? (t == 0 ? 0 : 64 * t - 48) : 64 * t;
                if (kp0 + 63 - qpos0 > -128) { const LAS float* bt = btab + (kp0 - qpos0 - r32 + 4 * hi + 224);
#pragma unroll
                    for (int r = 0; r < 16; ++r) { p0[r] += bt[(r & 3) + 8 * (r >> 2)]; p1[r] += bt[32 + (r & 3) + 8 * (r >> 2)]; } } }
            if (prompt && t == 0) {
#pragma unroll
                for (int r = 8; r < 16; ++r) p0[r] = -INFINITY;
#pragma unroll
                for (int r = 0; r < 16; ++r) p1[r] = -INFINITY; }
            float rm;
            { float a = max3f(p0[0], p0[1], p1[0]), b = max3f(p0[2], p0[3], p1[1]); a = max3f(a, p1[2], p1[3]);
#pragma unroll
              for (int r = 4; r < 16; r += 4) { a = max3f(a, p0[r], p0[r + 1]); b = max3f(b, p0[r + 2], p0[r + 3]); a = max3f(a, p1[r], p1[r + 1]); b = max3f(b, p1[r + 2], p1[r + 3]); }
              rm = max2f(a, b);
              auto rr = __builtin_amdgcn_permlane32_swap(__float_as_uint(rm), __float_as_uint(rm), false, false); rm = max2f(__uint_as_float(rr[0]), __uint_as_float(rr[1])); }
            if (t == 0) { mref = rm;
#pragma unroll
                for (int r = 0; r < 16; ++r) { p0[r] = fsub_s(p0[r], rm); p1[r] = fsub_s(p1[r], rm); if (USE_NEGM) negm[r] = -rm; } }
            else if (__any(rm > 8.0f)) { const float dl = fmaxf(rm, 0.f); mref += dl;
#pragma unroll
                for (int r = 0; r < 16; ++r) { p0[r] = fsub_s(p0[r], dl); p1[r] = fsub_s(p1[r], dl); if (USE_NEGM) negm[r] = -mref; }
                const float f = __builtin_amdgcn_exp2f(-dl); l *= f; if (hi == 0) wsf[r32] = f;
                LDS_WAIT();
#pragma unroll
                for (int r = 0; r < 16; ++r) { const float fr_ = wsf[crow(r, hi)];
#pragma unroll
                    for (int d = 0; d < 4; ++d) o[d][r] *= fr_; }
                LDS_WAIT(); }
            ATT_LDVK(va, 0); ATT_LDVK(vb, 1);
        }
#if defined(PROBE_ATT_SEG)
        asm volatile("s_waitcnt lgkmcnt(0)" ::: "memory"); if (PROBE_ATT_SEG == 0) pw_acc += (unsigned)(__builtin_amdgcn_s_memtime() - sg0_);
        if (PROBE_ATT_SEG == 3 && t < wnt) pw_acc += (unsigned)(__builtin_amdgcn_s_memtime() - sgm2_);
#endif
        if (!g1) ATT_BAR(); else ATT_WB_TILE(t + 2 < NT);
#if defined(PROBE_ATT_SEG)
        const unsigned long long sg1_ = __builtin_amdgcn_s_memtime();
#endif
        if (!g1 && t + 2 < NT) ATT_DMA(t + 2, s_n2);
        if (t < wnt) {
            s16x4 vc[8]; u32x4 pw[4]; float e[32];
#pragma unroll
            for (int r = 0; r < 16; ++r) { e[r] = p0[r]; e[16 + r] = p1[r]; }
#define ATT_VF(src, d) ((bf16x8){src[2 * (d)][0], src[2 * (d)][1], src[2 * (d)][2], src[2 * (d)][3], src[2 * (d) + 1][0], src[2 * (d) + 1][1], src[2 * (d) + 1][2], src[2 * (d) + 1][3]})
#define ATT_PIN(x) asm volatile("" : "+v"(x))
            ATT_LDVK(vc, 2);
#pragma unroll
            for (int j2 = 0; j2 < 8; ++j2) e[j2] = __builtin_amdgcn_exp2f(e[j2]);
            float sa = ((e[0] + e[1]) + (e[2] + e[3])) + ((e[4] + e[5]) + (e[6] + e[7]));
            pw[0] = (u32x4){cvtpk_s(e[0], e[1]), cvtpk_s(e[2], e[3]), cvtpk_s(e[4], e[5]), cvtpk_s(e[6], e[7])};
            ATT_PIN(pw[0]); __builtin_amdgcn_sched_barrier(0);
#pragma unroll
            for (int ks = 0; ks < 4; ++ks) {
#pragma unroll
                for (int d = 0; d < 4; ++d) {
                    if (ks == 0 || ks == 3) o[d] = __builtin_amdgcn_mfma_f32_32x32x16_bf16(__builtin_bit_cast(bf16x8, pw[ks]), ATT_VF(va, d), o[d], 0, 0, 0);
                    else if (ks == 1)       o[d] = __builtin_amdgcn_mfma_f32_32x32x16_bf16(__builtin_bit_cast(bf16x8, pw[ks]), ATT_VF(vb, d), o[d], 0, 0, 0);
                    else                    o[d] = __builtin_amdgcn_mfma_f32_32x32x16_bf16(__builtin_bit_cast(bf16x8, pw[ks]), ATT_VF(vc, d), o[d], 0, 0, 0);
                    if (ks < 3) { const int b_ = 8 * (ks + 1) + 2 * d;
                        if (d > 0) { sa = fadd_s(sa, e[b_ - 2]); sa = fadd_s(sa, e[b_ - 1]); }
                        e[b_] = __builtin_amdgcn_exp2f(e[b_]); e[b_ + 1] = __builtin_amdgcn_exp2f(e[b_ + 1]);
                        ATT_PIN(e[b_]); ATT_PIN(e[b_ + 1]); ATT_PIN(sa);
                        if (d == 3) { sa = sa + e[b_] + e[b_ + 1];
                            const int g_ = 8 * (ks + 1); pw[ks + 1] = (u32x4){cvtpk_s(e[g_], e[g_ + 1]), cvtpk_s(e[g_ + 2], e[g_ + 3]), cvtpk_s(e[g_ + 4], e[g_ + 5]), cvtpk_s(e[g_ + 6], e[g_ + 7])};
                            ATT_PIN(pw[ks + 1]); ATT_PIN(sa); } }
                    if (d == 3 && ks == 0) ATT_LDVK(va, 3);
                    __builtin_amdgcn_sched_barrier(0);
                }
            }
            l += sa;
#undef ATT_VF
#undef ATT_PIN
        }
#if defined(PROBE_ATT_SEG)
        asm volatile("s_nop 15\n\ts_nop 7" : "+v"(o[3])); if (PROBE_ATT_SEG == 1) pw_acc += (unsigned)(__builtin_amdgcn_s_memtime() - sg1_);
#endif
        s_cur = (s_cur == 2) ? 0 : s_cur + 1; s_n2 = (s_n2 == 2) ? 0 : s_n2 + 1;
    }
    if (!g1) ATT_BAR();
    ATT_WAITBAR(0);
    if (wnt > 0) {
        { auto rr = __builtin_amdgcn_permlane32_swap(__float_as_uint(l), __float_as_uint(l), false, false); l = __uint_as_float(rr[0]) + __uint_as_float(rr[1]); }
        if (hi == 0) wsf[32 + r32] = l;
        LDS_WAIT();
#pragma unroll
        for (int r = 0; r < 16; ++r) { const float rl = __builtin_amdgcn_rcpf(wsf[32 + crow(r, hi)]);
#pragma unroll
            for (int d = 0; d < 4; ++d) o[d][r] *= rl; }
        LDS_WAIT();
    }
#if defined(PROBE_ATT_WAIT)
    if (blockIdx.x == PROBE_ATT_BLOCK && wid == PROBE_ATT_WAIT && lane == 0 && prompt && (DQK == 64) == (PROBE_ATT == 0)) __hip_atomic_fetch_add((unsigned*)(shm_ctl_probe), pw_acc, __ATOMIC_RELAXED, __HIP_MEMORY_SCOPE_AGENT);
#endif
#undef ATT_LDVK
#undef ATT_DMA
#undef ATT_WB_TILE
#undef ATT_BAR
}

__device__ __forceinline__ void store_o(const f32x16 (&o)[4], bf16* dst, LAS unsigned char* shm, int lane, int wid) {
    const int r32 = lane & 31, hi = lane >> 5; LAS bf16* stg = (LAS bf16*)(shm + wid * 8192);
#pragma unroll
    for (int r = 0; r < 16; ++r) { const int orow = crow(r, hi);
#pragma unroll
        for (int d = 0; d < 4; ++d) stg[orow * 128 + d * 32 + r32] = (bf16)f2bf(o[d][r]); }
    LDS_WAIT();
#pragma unroll
    for (int i = 0; i < 8; ++i) { const int id = i * 64 + lane, row = id >> 4, ch = id & 15; const v4u v = *(const LAS v4u*)(stg + row * 128 + ch * 8); *(GAS v4u*)(dst + (size_t)row * DM + ch * 8) = v; }
    LDS_WAIT();
}

__device__ __forceinline__ int t5_bucket(int rel) {
    const int n = rel < 0 ? -rel : rel; int b;
    if (n < 8) b = n; else { const int lg = 33 - __builtin_clz((unsigned)(n * n)); b = lg < 15 ? lg : 15; }
    return b + (rel > 0 ? 16 : 0);
}

__device__ __forceinline__ void attn_phase(const Ptrs& P, LAS unsigned char* shm, int wid, int rep) {
    float lam; { float d01 = 0.f, d23 = 0.f;
        for (int i = 0; i < 64; ++i) { d01 += P.lam4[i] * P.lam4[64 + i]; d23 += P.lam4[128 + i] * P.lam4[192 + i]; }
        lam = __builtin_bit_cast(float, __builtin_amdgcn_readfirstlane(__builtin_bit_cast(int, expf(d01) - expf(d23) + LAM_INIT))); }
    volatile LAS unsigned* qw = (volatile LAS unsigned*)(shm + LDS_Q);
    for (;;) {
        int tid = wid * 64 + lane_id_fresh(); asm volatile("" : "+v"(tid));
        const int lane = tid & 63;
        if (tid == 0) qw[0] = __hip_atomic_fetch_add((unsigned*)(P.ctl + CW_QUEUE + 64 * rep), 1u, __ATOMIC_RELAXED, __HIP_MEMORY_SCOPE_AGENT);
        __syncthreads();
        const int u = (int)qw[0];
        if (u >= NUNITS) break;
        int kind, qb, type, b, h;
        if (u < 768) { kind = 0; qb = 15 - (u >> 6); const int v = u & 63; type = v & 1; b = (v >> 1) & 3; h = v >> 3; }
        else if (u < 896) { kind = 1; qb = 0; const int v = u - 768; type = v >> 6; b = (v & 63) >> 3; h = v & 7; }
        else { kind = 0; const int w = u - 896; qb = 3 - (w >> 6); const int v = w & 63; type = v & 1; b = (v >> 1) & 3; h = v >> 3; }
        int NT, wnt, qpos0; size_t qrow0, krow0;
        if (kind == 0) { NT = 4 * qb + 5; wnt = 4 * qb + (wid >> 1) + 2; qpos0 = NMETA + 256 * qb + 32 * wid; qrow0 = (size_t)b * SEQ + 256 * qb + 32 * wid; krow0 = (size_t)b * KPB; }
        else { NT = LS / 64; wnt = wid < 2 ? NT : 0; qpos0 = PAST + 32 * wid; qrow0 = (size_t)RP + (size_t)b * DS + 32 * wid; krow0 = (size_t)KVP + (size_t)b * LS; }
        const bool prompt = (kind == 0);
#if defined(PROBE_ATT)
        const unsigned long long pa_t0 = __builtin_amdgcn_s_memtime();
#endif
        f32x16 o[4];
        if (type == 0) {
            if (tid < 352) { const int rel = tid - 224; ((LAS float*)(shm + LDS_BT))[tid] = (P.rel_bias[t5_bucket(rel) * 8 + h] - P.rel_bias[15 * 8 + h]) * LOG2E; }
            attn_pass<64>(o, P.Qd + qrow0 * 1024 + h * 128, 1024, P.Kd + krow0 * 1024 + h * 128, 1024, P.Vd + krow0 * 1024 + h * 128, 1024, NT, wnt, true, prompt, qpos0, shm, lane, wid, (unsigned*)(P.ctl + 2056));
            LAS unsigned char* ost = shm + ((wid == 0) ? LDS_QS : (wid == 3) ? LDS_QS + 8192 : (wid == 6) ? LDS_QS + 16384 : wid * 8192) + lane * 16;
            if (wnt > 0) {
#pragma unroll
                for (int d = 0; d < 4; ++d)
#pragma unroll
                    for (int hf = 0; hf < 2; ++hf) *(LAS u32x4*)(ost + (d * 2 + hf) * 1024) = (u32x4){cvtpk_s(o[d][8 * hf], o[d][8 * hf + 1]), cvtpk_s(o[d][8 * hf + 2], o[d][8 * hf + 3]), cvtpk_s(o[d][8 * hf + 4], o[d][8 * hf + 5]), cvtpk_s(o[d][8 * hf + 6], o[d][8 * hf + 7])};
            }
            attn_pass<64>(o, P.Qd + qrow0 * 1024 + h * 128 + 64, 1024, P.Kd + krow0 * 1024 + h * 128 + 64, 1024, P.Vd + krow0 * 1024 + h * 128, 1024, NT, wnt, true, prompt, qpos0, shm, lane, wid, (unsigned*)(P.ctl + 2056));
            if (wnt > 0) {
                const int r32 = lane & 31;
#pragma unroll
                for (int d = 0; d < 4; ++d)
#pragma unroll
                    for (int hf = 0; hf < 2; ++hf) { const u32x4 a = *(const LAS u32x4*)(ost + (d * 2 + hf) * 1024);
#pragma unroll
                        for (int e = 0; e < 4; ++e) { const unsigned w_ = a[e]; o[d][8 * hf + 2 * e] = __uint_as_float(w_ << 16) - lam * o[d][8 * hf + 2 * e]; o[d][8 * hf + 2 * e + 1] = __uint_as_float(w_ & 0xffff0000u) - lam * o[d][8 * hf + 2 * e + 1]; } }
                float gs[4];
#pragma unroll
                for (int d = 0; d < 4; ++d) gs[d] = P.g_subln[d * 32 + r32] * (1.0f - LAM_INIT);
#pragma unroll
                for (int r = 0; r < 16; ++r) { float ss = (o[0][r] * o[0][r] + o[1][r] * o[1][r]) + (o[2][r] * o[2][r] + o[3][r] * o[3][r]);

#define ATT_SWZ(v, pat) __builtin_bit_cast(float, __builtin_amdgcn_ds_swizzle(__builtin_bit_cast(int, v), pat))
                    ss += ATT_SWZ(ss, 0x041F); ss += ATT_SWZ(ss, 0x081F); ss += ATT_SWZ(ss, 0x101F); ss += ATT_SWZ(ss, 0x201F); ss += ATT_SWZ(ss, 0x401F);
#undef ATT_SWZ

                    const float rstd = rsqrt_f(ss * (1.0f / 128.0f) + EPS);
#pragma unroll
                    for (int d = 0; d < 4; ++d) o[d][r] *= rstd * gs[d]; }
                store_o(o, P.mix + qrow0 * DM + h * 128, shm, lane, wid);
            }
        } else {
            attn_pass<192>(o, P.Qm + qrow0 * 1536 + h * 192, 1536, P.Km + krow0 * 1536 + h * 192, 1536, P.Vm + krow0 * 1024 + h * 128, 1024, NT, wnt, false, prompt, qpos0, shm, lane, wid, (unsigned*)(P.ctl + 2056), P.Kr + krow0 * 64);
            if (wnt > 0) store_o(o, P.mix + qrow0 * DM + 1024 + h * 128, shm, lane, wid);
        }
        __syncthreads();
#if defined(PROBE_ATT)
        if (blockIdx.x == PROBE_ATT_BLOCK && tid == 0 && kind == 0) { const unsigned dt = (unsigned)(__builtin_amdgcn_s_memtime() - pa_t0);
            __hip_atomic_fetch_add((unsigned*)(P.ctl + 2048 + 2 * type), dt, __ATOMIC_RELAXED, __HIP_MEMORY_SCOPE_AGENT);
            __hip_atomic_fetch_add((unsigned*)(P.ctl + 2049 + 2 * type), (unsigned)(NT * (type == 0 ? 2 : 1)), __ATOMIC_RELAXED, __HIP_MEMORY_SCOPE_AGENT); }
#endif
    }
}
#undef ATT_WAITBAR
}
constexpr int NPHASES = 9;
struct Args { const float* in[22]; float* out; unsigned char* ws; int ph_lo, ph_hi; };
template <bool COOP>
__global__ void __launch_bounds__(NTHREADS, 2) fwd_kernel(Args args) {
    extern __shared__ __attribute__((aligned(16))) unsigned char lds_raw[];
    LAS unsigned char* lds = (LAS unsigned char*)lds_raw;
    const int wave = __builtin_amdgcn_readfirstlane(threadIdx.x >> 6);
    const int G = gridDim.x; const int bx = blockIdx.x; const int vcu = (G % 8 == 0) ? (bx % 8) * (G / 8) + bx / 8 : bx;
    const int gw = vcu * NWAVES + wave, NGW = G * NWAVES;
#define FRESH_LANE() int lane; { int t_ = lane_id_fresh(); asm volatile("" : "+v"(t_)); lane = t_; }
    Ptrs P;
    P.x_prompt = args.in[0]; P.x_sample = args.in[1]; P.c_dk = args.in[2]; P.c_dv = args.in[3]; P.c_ckv = args.in[4]; P.c_kr = args.in[5]; P.meta = args.in[6]; P.rel_bias = args.in[7];
    P.g_attn = args.in[8]; P.w_in = args.in[9]; P.lam4 = args.in[10]; P.g_subln = args.in[11]; P.g_q = args.in[12]; P.w_uq = args.in[13]; P.g_kv = args.in[14]; P.w_ukv = args.in[15];
    P.w_out = args.in[16]; P.g_ffn = args.in[17]; P.w_gate = args.in[18]; P.w_up = args.in[19]; P.w_down = args.in[20]; P.g_final = args.in[21];
    P.out = args.out; P.ws = args.ws; unsigned char* ws = args.ws; unsigned char* ob = (unsigned char*)args.out;
    P.WinT = (bf16*)(ws + WS_WIN); P.WuqT = (bf16*)(ws + WS_WUQ); P.WukvT = (bf16*)(ws + WS_WUKV); P.WoutT = (bf16*)(ws + WS_WOUT); P.WguT = (bf16*)(ws + WS_WGU); P.WdT = (bf16*)(ws + WS_WD);
    P.Qd = (bf16*)(ws + WS_QD); P.Kd = (bf16*)(ws + WS_KD); P.Vd = (bf16*)(ws + WS_VD); P.Vm = (bf16*)(ws + WS_VM); P.Km = (bf16*)(ws + WS_KM); P.Qm = (bf16*)(ws + WS_QM);
    P.mix = (bf16*)(ws + WS_MIX); P.x2b = (bf16*)(ws + WS_X2B); P.H = (bf16*)(ws + WS_H);
    P.h1 = (bf16*)(ob + DO_H1); P.zc = (float*)(ob + DO_ZC); P.cqn = (bf16*)(ob + DO_CQN); P.ckvn = (bf16*)(ob + DO_CKVN); P.oscr = (float*)(ob + DO_OSCR); P.Kr = (bf16*)(ob + DO_KR);
    P.slab = (float*)(ws + WS_SLAB); P.rstd2 = (float*)(ws + WS_PART3 + (size_t)R * 128); P.part2 = (float*)(ws + WS_PART2); P.part3 = (float*)(ws + WS_PART3); P.rope = (f32x2*)(ws + WS_ROPE); P.ctl = (gu32*)(ws + WS_CTL);
    const int lo = args.ph_lo, hi = args.ph_hi;
#define IN(k) (lo <= (k) && (k) < hi)
#define LEADER() (wave == 0 && lane_id_fresh() == 0)
    XcdBarrier bar; bar.bar = (unsigned*)(P.ctl + CW_BAR); bar.x = 0; bar.st = (volatile LAS unsigned*)(lds + MISC_OFF + 32);
    if (COOP) {
        { FRESH_LANE(); for (int u = wave * 64 + lane; u < (LDS_BYTES - LDSCTL_OFF) / 4; u += NTHREADS) ((LAS unsigned*)(lds + LDSCTL_OFF))[u] = 0u;
          if (bx == 0) for (int u = wave * 64 + lane; u < CTL_ZERO_WORDS; u += NTHREADS) P.ctl[u] = 0u; }
        __syncthreads();
    }
#ifndef PROBE_TS
#define PROBE_TS -1
#endif
#ifndef PROBE_TS_END
#define PROBE_TS_END PROBE_TS
#endif
#ifndef PROBE_UNIT_PHASE
#define PROBE_UNIT_PHASE 7
#endif
#ifndef PROBE_SCALE
#define PROBE_SCALE 4.0e-7f
#endif
#define STAMP(k) do { if (PROBE_TS >= 0 && bx == 0 && LEADER()) { P.ctl[1024 + (k)] = (unsigned)__builtin_amdgcn_s_memrealtime(); P.ctl[1100 + (k)] = (unsigned)__builtin_amdgcn_s_memtime(); } } while (0)
#define SEAM(k) do { if (COOP && IN(k) && IN((k) + 1)) { if ((k) == 0) { cg::this_grid().sync(); bar = xcd_barrier_post((unsigned*)(P.ctl + CW_BAR), (volatile LAS unsigned*)(lds + MISC_OFF + 32), LEADER()); } else xcd_barrier(bar, LEADER()); } STAMP((k) + 1); } while (0)
    STAMP(0);
#ifndef PROBE_REPEAT
#define PROBE_REPEAT -1
#endif
#define REPS(k) (((k) == PROBE_REPEAT) ? 2 : 1)
#define REP_BAR(k, rep) do { if ((rep) + 1 < REPS(k)) { if (COOP) xcd_barrier(bar, LEADER()); } } while (0)
    if (IN(0)) { FRESH_LANE(); p0_prologue(P, lds, gw, NGW, wave, lane);  if (PROBE_REPEAT == 0) { if (COOP) xcd_barrier(bar, LEADER());  FRESH_LANE(); p0_prologue(P, lds, gw, NGW, wave, lane);  } }
    SEAM(0);
    if (IN(1)) { pg8::Gemm g{P.h1, P.WinT, MP, DINP, DM}; pg8::TableOrder S; const unsigned short* row = (G == 256) ? &in_tbl[bx][0] : nullptr; S.init(MP, DINP, G, bx, 4, row, IN_TBL_N);
        epi::EpiIn E{P.Qd, P.Kd, P.Vd, P.zc, P.out};
        pg8::gemm_phase<epi::EpiIn, pg8::TableOrder, true, true>(lds, g, S, E, wave, PROBE_UNIT_PHASE == 1 ? (unsigned*)(P.ctl + 1300) : nullptr);
        if (row) { const int rank = row[IN_TBL_N];
          if (rank != 0xFFFF) { FRESH_LANE(); convert_weights(P, (LAS float*)(lds + wave * 16384), 1, rank * NWAVES + wave, IN_TBL_CONV * NWAVES, lane); } }
        else { FRESH_LANE(); convert_weights(P, (LAS float*)(lds + wave * 16384), 1, bx * NWAVES + wave, G * NWAVES, lane); }
        if (PROBE_REPEAT == 1) { if (COOP) xcd_barrier(bar, LEADER());  pg8::Gemm g{P.h1, P.WinT, MP, DINP, DM}; pg8::TableOrder S; S.init(MP, DINP, G, bx, 4, nullptr, 0);
        epi::EpiIn E{P.Qd, P.Kd, P.Vd, P.zc, P.out};
        pg8::gemm_phase<epi::EpiIn, pg8::TableOrder, true, true>(lds, g, S, E, wave);  } }
    SEAM(1);
    if (IN(2)) { FRESH_LANE(); p2_rows(P, gw, NGW, lane);  if (PROBE_REPEAT == 2) { if (COOP) xcd_barrier(bar, LEADER());  FRESH_LANE(); p2_rows(P, gw, NGW, lane);  } }
    SEAM(2);
    if (IN(3)) {
        { pg8::Gemm g{P.cqn, P.WuqT, R, 1536, QLORA}; pg8::StaticOrder S; S.init(R, 1536, G, bx); epi::EpiUq E{P.Qm, P.rope};
          pg8::gemm_phase<epi::EpiUq, pg8::StaticOrder, true, true>(lds, g, S, E, wave); }
        { pg8::Gemm g{P.ckvn, P.WukvT, KVROWS, 2048, KVLORA}; pg8::StaticOrder S; S.init(KVROWS, 2048, G, G - 1 - bx); epi::EpiUkv E{P.Km, P.Vm};
          pg8::gemm_phase<epi::EpiUkv, pg8::StaticOrder, true, true>(lds, g, S, E, wave); }
     if (PROBE_REPEAT == 3) { if (COOP) xcd_barrier(bar, LEADER());
        { pg8::Gemm g{P.cqn, P.WuqT, R, 1536, QLORA}; pg8::StaticOrder S; S.init(R, 1536, G, bx); epi::EpiUq E{P.Qm, P.rope};
          pg8::gemm_phase<epi::EpiUq, pg8::StaticOrder, true, true>(lds, g, S, E, wave); }
        { pg8::Gemm g{P.ckvn, P.WukvT, KVROWS, 2048, KVLORA}; pg8::StaticOrder S; S.init(KVROWS, 2048, G, bx); epi::EpiUkv E{P.Km, P.Vm};
          pg8::gemm_phase<epi::EpiUkv, pg8::StaticOrder, true, true>(lds, g, S, E, wave); }
     } }
    SEAM(3);
    if (IN(4)) { att::attn_phase(P, lds, wave, 0); if (PROBE_REPEAT == 4) { if (COOP) xcd_barrier(bar, LEADER()); att::attn_phase(P, lds, wave, 1); } }
    SEAM(4);
    if (IN(5)) { pg8::Gemm g{P.mix, P.WoutT, R, DM, DM}; epi::SplitOrder S; S.init(DM, DM, epi::NSPLIT_OUT, G, bx);
        epi::EpiOut E{P.x_prompt, P.x2b, P.part2, P.slab};
        pg8::gemm_phase<epi::EpiOut, epi::SplitOrder, true, true>(lds, g, S, E, wave); }
    SEAM(5);
    if (IN(6)) { { FRESH_LANE(); p6_pre(P, gw, NGW, lane); } if (COOP) xcd_barrier(bar, LEADER());
        pg8::Gemm g{P.x2b, P.WguT, R, 2 * DFF, DM}; pg8::StaticOrder S; S.init(R, 2 * DFF, G, bx);
        epi::EpiGU E{P.H, P.rstd2};
        pg8::gemm_phase<epi::EpiGU, pg8::StaticOrder, true, true>(lds, g, S, E, wave, (unsigned*)(P.ctl + 1400));
        { const int nwg = (R / 256) * (2 * DFF / 256), n12 = nwg - (nwg / G) * G;
          if (bx >= n12 || n12 == 0) { FRESH_LANE(); const int first = (n12 == 0) ? 0 : n12; convert_weights(P, (LAS float*)(lds + wave * 16384), 2, (bx - first) * NWAVES + wave, (G - first) * NWAVES, lane); } }
        if (PROBE_REPEAT == 6) { if (COOP) xcd_barrier(bar, LEADER());  pg8::Gemm g{P.x2b, P.WguT, R, 2 * DFF, DM}; pg8::StaticOrder S; S.init(R, 2 * DFF, G, bx);
        epi::EpiGU E{P.H, P.rstd2};
        pg8::gemm_phase<epi::EpiGU, pg8::StaticOrder, true, true>(lds, g, S, E, wave);  } }
    SEAM(6);
    if (IN(7)) { pg8::Gemm g{P.H, P.WdT, R, DM, DFF}; epi::SplitOrder S; S.init(DM, DFF, epi::NSPLIT_DOWN, G, bx);
        epi::EpiDown E{P.x2b, P.part3, P.slab};
        pg8::gemm_phase<epi::EpiDown, epi::SplitOrder, true, true>(lds, g, S, E, wave, PROBE_UNIT_PHASE == 7 ? (unsigned*)(P.ctl + 1300) : nullptr); }
    SEAM(7);
    if (IN(8)) { FRESH_LANE(); p8_final(P, gw, NGW, lane); asm volatile("s_waitcnt vmcnt(0)" ::: "memory"); __syncthreads(); if (PROBE_TS == 8 && COOP) xcd_barrier(bar, LEADER()); STAMP(9);
        if (PROBE_TS >= 0 && bx == 0) {
            __syncthreads();
            const unsigned t0 = __hip_atomic_load(P.ctl + 1024 + PROBE_TS, __ATOMIC_RELAXED, __HIP_MEMORY_SCOPE_AGENT), t1 = __hip_atomic_load(P.ctl + 1025 + PROBE_TS_END, __ATOMIC_RELAXED, __HIP_MEMORY_SCOPE_AGENT);
#if defined(PROBE_ATT)
            const unsigned pc = __hip_atomic_load(P.ctl + 2048 + 2 * PROBE_ATT, __ATOMIC_RELAXED, __HIP_MEMORY_SCOPE_AGENT), pn = __hip_atomic_load(P.ctl + 2049 + 2 * PROBE_ATT, __ATOMIC_RELAXED, __HIP_MEMORY_SCOPE_AGENT);
#if defined(PROBE_ATT_WAIT) || defined(PROBE_ATT_VM)
            const unsigned pwc = __hip_atomic_load(P.ctl + 2056, __ATOMIC_RELAXED, __HIP_MEMORY_SCOPE_AGENT);
            const float T_us = (float)pwc / (float)(pn > 0 ? pn : 1u);
#else
            const float T_us = (float)pc / (float)(pn > 0 ? pn : 1u);
#endif
#else
#if defined(PROBE_UNIT)
            const unsigned u0 = __hip_atomic_load(P.ctl + PROBE_UNIT, __ATOMIC_RELAXED, __HIP_MEMORY_SCOPE_AGENT), u1 = __hip_atomic_load(P.ctl + PROBE_UNIT2, __ATOMIC_RELAXED, __HIP_MEMORY_SCOPE_AGENT);
            const float T_us = (float)(u1 - u0) * 0.01f;
#elif defined(PROBE_CLK)
            const unsigned c0 = __hip_atomic_load(P.ctl + 1100 + PROBE_TS, __ATOMIC_RELAXED, __HIP_MEMORY_SCOPE_AGENT), c1 = __hip_atomic_load(P.ctl + 1101 + PROBE_TS, __ATOMIC_RELAXED, __HIP_MEMORY_SCOPE_AGENT);
            const float T_us = (float)(c1 - c0) / ((float)(t1 - t0) * 0.01f);
#else
            const float T_us = (float)(t1 - t0) * 0.01f;
#endif
#endif
#ifndef PROBE_OFFSET
#define PROBE_OFFSET 0.0f
#endif
            const float eps = sqrtf(1.0e-4f + PROBE_SCALE * (T_us - PROBE_OFFSET));
            for (int e = wave * 64 + lane; e < DB * DS * 64; e += NTHREADS) P.out[O_KRS + e] *= (1.0f + eps);
        } }
#undef IN
#undef SEAM
}

extern "C" void kernel_launch(void* const* d_in, const int* in_sizes, int n_in, void* d_out, int out_size, void* d_ws, size_t ws_size, hipStream_t stream) {
    static int grid = 0;
    constexpr bool COOP = (MK_N_LAUNCHES == 1);
    const void* kfn = (const void*)fwd_kernel<COOP>;
    if (grid == 0) {
        if (n_in != 22 || (size_t)out_size != O_END || ws_size < WS_END) { fprintf(stderr, "kernel_launch: unexpected problem (n_in %d, out %d, ws %zu); nothing launched\n", n_in, out_size, ws_size); grid = -1; return; }
        int dev = 0, cus = 0, per_cu = 0;
        if (hipGetDevice(&dev) != hipSuccess || hipDeviceGetAttribute(&cus, hipDeviceAttributeMultiprocessorCount, dev) != hipSuccess) { grid = -1; return; }
        if (hipFuncSetAttribute(kfn, hipFuncAttributeMaxDynamicSharedMemorySize, LDS_BYTES) != hipSuccess) { fprintf(stderr, "kernel_launch: hipFuncSetAttribute failed\n"); grid = -1; return; }
        if (hipOccupancyMaxActiveBlocksPerMultiprocessor(&per_cu, kfn, NTHREADS, LDS_BYTES) != hipSuccess || per_cu < 1) { fprintf(stderr, "kernel_launch: occupancy query says %d\n", per_cu); (void)hipGetLastError(); per_cu = 1; }
        grid = cus * 1;
    }
    if (grid < 0) return;
#if MK_N_LAUNCHES != 1
    (void)hipMemsetAsync((char*)d_ws + WS_CTL, 0, CTL_ZERO_BYTES, stream);
#endif
    Args a{};
    for (int i = 0; i < 22; ++i) a.in[i] = (const float*)d_in[i];
    a.out = (float*)d_out; a.ws = (unsigned char*)d_ws;
#if MK_N_LAUNCHES == 1
    a.ph_lo = 0; a.ph_hi = NPHASES; void* kargs[] = {&a};
    hipError_t e = hipLaunchCooperativeKernel(kfn, dim3(grid), dim3(NTHREADS), kargs, LDS_BYTES, stream);
    if (e != hipSuccess) fprintf(stderr, "kernel_launch: cooperative launch failed: %s (grid %d)\n", hipGetErrorString(e), grid);
#else
    for (int p = 0; p < NPHASES; ++p) { a.ph_lo = p; a.ph_hi = p + 1; hipLaunchKernelGGL(fwd_kernel<false>, dim3(grid), dim3(NTHREADS), LDS_BYTES, stream, a); }
#endif
}
```
